# Optimizing an MI355X kernel written in HIP

```python
import jax, jax.numpy as jnp
from jax import lax
import numpy as np

D_MODEL = 1024
BATCH = 8
SEQ = 8192
DEPTH = 4

GRID_W = 64
CTX_LEN = 256
RMS_EPS = 1e-6
N_DIR = 2
REC_CHUNK = 64
A_HEADS = 4
A_HEAD_DIM = 3 * D_MODEL // 32
A_WIDTH = A_HEADS * A_HEAD_DIM
CONV_W = 3
B_GROUPS = 4
B_WIDTH = D_MODEL // 4
B_GROUP_DIM = B_WIDTH // B_GROUPS
B_CHUNK = 128
C_HEADS = 4
C_WIDTH = D_MODEL - A_WIDTH - B_WIDTH
C_HEAD_DV = C_WIDTH // C_HEADS
C_HEAD_DK = C_HEAD_DV // 2
C_KEY_WIDTH = C_HEADS * C_HEAD_DK
C_GATE_RANK = 16
C_GATE_NORM = 16.0
D_FF = ((8 * D_MODEL // 3 + 255) // 256) * 256
IN_SIZES = (A_WIDTH, A_WIDTH, A_WIDTH, A_WIDTH, N_DIR * 2 * A_HEADS,
            B_WIDTH, B_WIDTH,
            C_KEY_WIDTH, C_KEY_WIDTH, C_WIDTH, C_WIDTH, N_DIR * C_GATE_RANK)
N_IN = sum(IN_SIZES)

kernel_name = 'hybrid_mlstm_sgu_gla_dit'


def rmsnorm(x, g):
    xf = x.astype(jnp.float32)
    y = xf * lax.rsqrt(jnp.mean(xf * xf, axis=-1, keepdims=True) + RMS_EPS)
    return (y * g.astype(jnp.float32)).astype(x.dtype)


def modulate(h, shift, scale):
    return h * (1 + scale) + shift


def centred_dwconv(x, w):
    pad = CONV_W // 2
    t_len = x.shape[1]
    xp = jnp.pad(x, ((0, 0), (pad, pad), (0, 0)))
    return sum(w[j] * xp[:, j:j + t_len] for j in range(CONV_W))


def split_heads(a, n_heads):
    bsz, t_len, _ = a.shape
    return a.reshape(bsz, t_len, n_heads, -1).transpose(0, 2, 1, 3)


def to_chunks(a):
    t_len = a.shape[2]
    a = a.reshape(a.shape[:2] + (t_len // REC_CHUNK, REC_CHUNK) + a.shape[3:])
    return jnp.moveaxis(a, 2, 0)


def from_chunks(a):
    a = jnp.moveaxis(a, 0, 2)
    return a.reshape(a.shape[:2] + (a.shape[2] * a.shape[3],) + a.shape[4:])


def raster_to_column(h, rows):
    bsz, t_len, d = h.shape
    return h.reshape(bsz, rows, GRID_W, d).transpose(0, 2, 1, 3).reshape(bsz, t_len, d)


def column_to_raster(h, rows):
    bsz, t_len, d = h.shape
    return h.reshape(bsz, GRID_W, rows, d).transpose(0, 2, 1, 3).reshape(bsz, t_len, d)


def mlstm_scan(q, k, v, log_i, log_f, state):
    tril = jnp.tril(jnp.ones((REC_CHUNK, REC_CHUNK), dtype=bool))

    def step(carry, xs):
        C, n, m = carry
        qc, kc, vc, ic, fc = xs
        b = jnp.cumsum(fc, axis=-1)
        d_log = jnp.where(tril, b[..., :, None] - b[..., None, :] + ic[..., None, :], -jnp.inf)
        inter_log = b + m[..., None]
        m_t = jnp.maximum(inter_log, jnp.max(d_log, axis=-1))
        s = jnp.einsum('bhtd,bhsd->bhts', qc, kc) * jnp.exp(d_log - m_t[..., None])
        inter = jnp.exp(inter_log - m_t)
        num = jnp.einsum('bhts,bhse->bhte', s, vc) + inter[..., None] * jnp.einsum('bhed,bhtd->bhte', C, qc)
        den = jnp.sum(s, axis=-1) + inter * jnp.einsum('bhd,bhtd->bht', n, qc)
        h = num / jnp.maximum(jnp.abs(den), jnp.exp(-m_t))[..., None]
        b_last = b[..., -1]
        w_log = b_last[..., None] - b + ic
        m_new = jnp.maximum(b_last + m, jnp.max(w_log, axis=-1))
        decay = jnp.exp(b_last + m - m_new)
        w = jnp.exp(w_log - m_new[..., None])
        C_new = decay[..., None, None] * C + jnp.einsum('bhs,bhse,bhsd->bhed', w, vc, kc)
        n_new = decay[..., None] * n + jnp.einsum('bhs,bhsd->bhd', w, kc)
        return (C_new, n_new, m_new), h

    state, h = lax.scan(step, state, tuple(to_chunks(a) for a in (q, k, v, log_i, log_f)))
    return state, from_chunks(h)


def gla_scan(q, k, v, log_a, S):
    tril = jnp.tril(jnp.ones((REC_CHUNK, REC_CHUNK), dtype=bool))[:, :, None]

    def step(S, xs):
        qc, kc, vc, ac = xs
        b = jnp.cumsum(ac, axis=2)
        rel = jnp.where(tril, b[:, :, :, None, :] - b[:, :, None, :, :], -jnp.inf)
        att = jnp.einsum('bhtd,bhsd,bhtsd->bhts', qc, kc, jnp.exp(rel))
        o = jnp.einsum('bhts,bhse->bhte', att, vc) + jnp.einsum('bhtd,bhde->bhte', qc * jnp.exp(b), S)
        b_last = b[:, :, -1:, :]
        S_new = jnp.exp(b_last[:, :, 0, :])[..., None] * S + \
            jnp.einsum('bhsd,bhse->bhde', kc * jnp.exp(b_last - b), vc)
        return S_new, o

    S, o = lax.scan(step, S, tuple(to_chunks(a) for a in (q, k, v, log_a)))
    return S, from_chunks(o)


def bidirectional(scan_fn, ctx_shared, lat_shared, ctx_gates, lat_gates, init):
    outs_ctx, outs_lat = [], []
    for d in range(N_DIR):
        flip = (lambda a: jnp.flip(a, axis=2)) if d == 1 else (lambda a: a)
        state, h_ctx = scan_fn(*[flip(a) for a in ctx_shared + ctx_gates[d]], init)
        _, h_lat = scan_fn(*[flip(a) for a in lat_shared + lat_gates[d]], state)
        outs_ctx.append(flip(h_ctx))
        outs_lat.append(flip(h_lat))
    return outs_ctx[0] + outs_ctx[1], outs_lat[0] + outs_lat[1]


def mixer_streams(h, w_in, mlstm_conv, mlstm_gate_b, gla_w_gk2, gla_b_gk):
    bsz, t_len, _ = h.shape
    points = [int(p) for p in np.cumsum(IN_SIZES)[:-1]]
    qa, ka, va, oa, ga, ub, vb, qc, kc, vc, gc, gkc = jnp.split(h @ w_in, points, axis=-1)
    f32 = lambda a: a.astype(jnp.float32)
    qk = jax.nn.silu(centred_dwconv(jnp.concatenate([qa, ka], axis=-1), mlstm_conv))
    qa, ka = jnp.split(qk, 2, axis=-1)
    a_shared = (f32(split_heads(qa, A_HEADS)) * A_HEAD_DIM ** -0.5,
                f32(split_heads(ka, A_HEADS)), f32(split_heads(va, A_HEADS)))
    g = f32(ga).reshape(bsz, t_len, N_DIR, 2, A_HEADS) + f32(mlstm_gate_b)
    g = g.transpose(2, 3, 0, 4, 1)
    a_gates = tuple((g[d, 0], jax.nn.log_sigmoid(g[d, 1])) for d in range(N_DIR))
    c_shared = (f32(split_heads(qc, C_HEADS)) * C_HEAD_DK ** -0.5,
                f32(split_heads(kc, C_HEADS)), f32(split_heads(vc, C_HEADS)))
    gk = jnp.einsum('btdr,drk->dbtk', f32(gkc).reshape(bsz, t_len, N_DIR, C_GATE_RANK), f32(gla_w_gk2)) \
        + f32(gla_b_gk)[:, None, None, :]
    log_a = jax.nn.log_sigmoid(gk) / C_GATE_NORM
    c_gates = tuple((split_heads(log_a[d], C_HEADS),) for d in range(N_DIR))
    return a_shared, a_gates, c_shared, c_gates, (oa, gc, ub, vb)


def spatial_gating(ub, vb, norm_g, w_s, b_s):
    bsz, t_len, _ = vb.shape
    u = jax.nn.gelu(ub)
    v = rmsnorm(jax.nn.gelu(vb), norm_g).reshape(bsz, t_len // B_CHUNK, B_CHUNK, B_GROUPS, B_GROUP_DIM)
    mixed = jnp.einsum('gts,bnsgc->bntgc', w_s, v) + b_s.T[:, :, None]
    return u * mixed.reshape(bsz, t_len, B_WIDTH)


def mixer_output(a_h, c_h, oa, gc, ub, vb, mlstm_norm_g, gla_norm_g, sgu_norm_g, sgu_w, sgu_b, w_out):
    bsz, t_len, _ = oa.shape
    dt = oa.dtype
    a = rmsnorm(a_h.transpose(0, 2, 1, 3), mlstm_norm_g.reshape(A_HEADS, A_HEAD_DIM))
    a = a.reshape(bsz, t_len, A_WIDTH).astype(dt) * jax.nn.sigmoid(oa)
    cc = rmsnorm(c_h.transpose(0, 2, 1, 3), gla_norm_g).reshape(bsz, t_len, C_WIDTH).astype(dt) * jax.nn.silu(gc)
    s = spatial_gating(ub, vb, sgu_norm_g, sgu_w, sgu_b)
    return jnp.concatenate([a, s, cc], axis=-1) @ w_out


def mixer(h_ctx, h_lat, w_in, mlstm_conv, mlstm_gate_b, mlstm_norm_g, gla_w_gk2, gla_b_gk, gla_norm_g,
          sgu_norm_g, sgu_w, sgu_b, w_out, need_ctx):
    sc = mixer_streams(h_ctx, w_in, mlstm_conv, mlstm_gate_b, gla_w_gk2, gla_b_gk)
    sl = mixer_streams(h_lat, w_in, mlstm_conv, mlstm_gate_b, gla_w_gk2, gla_b_gk)
    bsz = h_lat.shape[0]
    a_init = (jnp.zeros((bsz, A_HEADS, A_HEAD_DIM, A_HEAD_DIM), jnp.float32),
              jnp.zeros((bsz, A_HEADS, A_HEAD_DIM), jnp.float32),
              jnp.zeros((bsz, A_HEADS), jnp.float32))
    c_init = jnp.zeros((bsz, C_HEADS, C_HEAD_DK, C_HEAD_DV), jnp.float32)
    a_ctx, a_lat = bidirectional(mlstm_scan, sc[0], sl[0], sc[1], sl[1], a_init)
    c_ctx, c_lat = bidirectional(gla_scan, sc[2], sl[2], sc[3], sl[3], c_init)
    o_lat = mixer_output(a_lat, c_lat, *sl[4], mlstm_norm_g, gla_norm_g, sgu_norm_g, sgu_w, sgu_b, w_out)
    o_ctx = mixer_output(a_ctx, c_ctx, *sc[4], mlstm_norm_g, gla_norm_g, sgu_norm_g, sgu_w, sgu_b, w_out) \
        if need_ctx else None
    return o_ctx, o_lat


def swiglu(h, w_in, w_out):
    gate, up = jnp.split(h @ w_in, 2, axis=-1)
    return (jax.nn.silu(gate) * up) @ w_out


def setup_inputs(seed: int = 0) -> dict:
    key = jax.random.key(seed)
    ks = jax.random.split(key, 24)
    nrm = lambda k, shape, scale: scale * jax.random.normal(k, shape, jnp.float32)
    gate_base = jnp.array([0.0, 3.0], jnp.float32)[None, :, None]
    return {
        'x': nrm(ks[0], (BATCH, SEQ, D_MODEL), 1.0),
        'c': nrm(ks[1], (BATCH, D_MODEL), 1.0),
        'ctx': nrm(ks[2], (BATCH, CTX_LEN, D_MODEL), 1.0),
        'c_ctx': nrm(ks[3], (D_MODEL,), 1.0),
        'norm1_g': 1.0 + nrm(ks[4], (DEPTH, D_MODEL), 0.02),
        'norm2_g': 1.0 + nrm(ks[5], (DEPTH, D_MODEL), 0.02),
        'w_ada': nrm(ks[6], (DEPTH, D_MODEL, 6 * D_MODEL), 0.5 * D_MODEL ** -0.5),
        'b_ada': nrm(ks[7], (DEPTH, 6 * D_MODEL), 0.02),
        'w_in': nrm(ks[8], (DEPTH, D_MODEL, N_IN), D_MODEL ** -0.5),
        'mlstm_conv': nrm(ks[9], (DEPTH, CONV_W, 2 * A_WIDTH), CONV_W ** -0.5),
        'mlstm_gate_b': gate_base + nrm(ks[10], (DEPTH, N_DIR, 2, A_HEADS), 0.3),
        'mlstm_norm_g': 1.0 + nrm(ks[11], (DEPTH, A_WIDTH), 0.02),
        'gla_w_gk2': nrm(ks[12], (DEPTH, N_DIR, C_GATE_RANK, C_KEY_WIDTH), C_GATE_RANK ** -0.5),
        'gla_b_gk': nrm(ks[13], (DEPTH, N_DIR, C_KEY_WIDTH), 0.1),
        'gla_norm_g': 1.0 + nrm(ks[14], (DEPTH, C_HEAD_DV), 0.02),
        'sgu_norm_g': 1.0 + nrm(ks[15], (DEPTH, B_WIDTH), 0.02),
        'sgu_w': nrm(ks[16], (DEPTH, B_GROUPS, B_CHUNK, B_CHUNK), B_CHUNK ** -0.5),
        'sgu_b': 1.0 + nrm(ks[17], (DEPTH, B_GROUPS, B_CHUNK), 0.02),
        'w_out': nrm(ks[18], (DEPTH, D_MODEL, D_MODEL), D_MODEL ** -0.5),
        'w_ffn_in': nrm(ks[19], (DEPTH, D_MODEL, 2 * D_FF), D_MODEL ** -0.5),
        'w_ffn_out': nrm(ks[20], (DEPTH, D_FF, D_MODEL), D_FF ** -0.5),
        'final_g': 1.0 + nrm(ks[21], (D_MODEL,), 0.02),
    }


def reference(x, c, ctx, c_ctx, norm1_g, norm2_g, w_ada, b_ada, w_in, mlstm_conv, mlstm_gate_b,
              mlstm_norm_g, gla_w_gk2, gla_b_gk, gla_norm_g, sgu_norm_g, sgu_w, sgu_b, w_out,
              w_ffn_in, w_ffn_out, final_g):
    rows = x.shape[1] // GRID_W
    x_lat, x_ctx = x, ctx
    s_lat = jax.nn.silu(c)
    s_ctx = jax.nn.silu(c_ctx)
    for l in range(DEPTH):
        need_ctx = l < DEPTH - 1
        mod_lat = (s_lat @ w_ada[l] + b_ada[l])[:, None, :]
        mod_ctx = (s_ctx @ w_ada[l] + b_ada[l])[None, None, :]
        sh1, sc1, g1, sh2, sc2, g2 = jnp.split(mod_lat, 6, axis=-1)
        csh1, csc1, cg1, csh2, csc2, cg2 = jnp.split(mod_ctx, 6, axis=-1)
        h_lat = modulate(rmsnorm(x_lat, norm1_g[l]), sh1, sc1)
        h_ctx = modulate(rmsnorm(x_ctx, norm1_g[l]), csh1, csc1)
        column_major = l % 2 == 1
        if column_major:
            h_lat = raster_to_column(h_lat, rows)
        o_ctx, o_lat = mixer(h_ctx, h_lat, w_in[l], mlstm_conv[l], mlstm_gate_b[l], mlstm_norm_g[l],
                             gla_w_gk2[l], gla_b_gk[l], gla_norm_g[l], sgu_norm_g[l], sgu_w[l], sgu_b[l],
                             w_out[l], need_ctx)
        if column_major:
            o_lat = column_to_raster(o_lat, rows)
        x_lat = x_lat + g1 * o_lat
        x_lat = x_lat + g2 * swiglu(modulate(rmsnorm(x_lat, norm2_g[l]), sh2, sc2), w_ffn_in[l], w_ffn_out[l])
        if need_ctx:
            x_ctx = x_ctx + cg1 * o_ctx
            x_ctx = x_ctx + cg2 * swiglu(modulate(rmsnorm(x_ctx, norm2_g[l]), csh2, csc2),
                                         w_ffn_in[l], w_ffn_out[l])
    return rmsnorm(x_lat, final_g)
```

```cpp
#include <hip/hip_runtime.h>
#include <hip/hip_cooperative_groups.h>
#include <cstdio>
namespace cg = cooperative_groups;
namespace pg8 {
#define PG8_LAS __attribute__((address_space(3)))
typedef unsigned short bf16_t;
typedef short bf16x8 __attribute__((ext_vector_type(8)));
typedef float f32x4 __attribute__((ext_vector_type(4)));
typedef unsigned u32x4 __attribute__((ext_vector_type(4)));
constexpr int BM = 256, BK = 64, HALF = 128, HTB = HALF * BK * 2  , STAGE_BYTES = 8 * HTB, NXCD = 8, WGM = 8;

__host__ __device__ __forceinline__ int lds_byte(int r, int c) { const int st = (r >> 4) * 2 + (c >> 5), rr = r & 15, cc = c & 31, ob = rr * 64 + cc * 2; return st * 1024 + (ob ^ (((ob >> 9) & 1) << 5)); }
__host__ __device__ __forceinline__ void stage_rc(int b, int& R, int& C) { const int st = b / 1024, sb = b % 1024, swz = sb ^ (((sb >> 9) & 1) << 5); R = (st >> 1) * 16 + swz / 64; C = (st & 1) * 32 + (swz % 64) / 2; }
__host__ __device__ __forceinline__ int perm32(int rho) { const int n = rho >> 4, i = rho & 15; return 8 * (i >> 2) + 4 * n + (i & 3); }

struct Unit { int pm, pn; };
struct Gemm { const bf16_t* A; const bf16_t* Bt; int M, N, K; };

struct StaticOrder {
    int nM, nN, nwg, G, c;
    __host__ __device__ void init(int M, int N, int G_, int c_) { nM = M / BM; nN = N / BM; nwg = nM * nN; G = G_; c = c_; }
    __host__ __device__ bool next(int i, Unit& u) const {
        const long L = (long)i * G + c; if (L >= nwg) return false;
        int wgid = (int)L; { const int q = nwg / NXCD, r = nwg % NXCD, xcd = wgid % NXCD, off = wgid / NXCD; wgid = (xcd < r ? xcd * (q + 1) : r * (q + 1) + (xcd - r) * q) + off; }
        const int nig = WGM * nN, gid = wgid / nig, fm = gid * WGM, gsz = (nM - fm) < WGM ? (nM - fm) : WGM;
        u.pm = fm + ((wgid % nig) % gsz); u.pn = (wgid % nig) / gsz; return true;
    }
    __device__ __forceinline__ void a_ready(const Unit&) const {}
    __device__ __forceinline__ void done(const Unit&) const {}
};
typedef float f32x2 __attribute__((ext_vector_type(2)));
typedef __bf16 bf16x2_n __attribute__((ext_vector_type(2)));
__device__ __forceinline__ unsigned cvt_pk_bf16(float lo, float hi) { f32x2 v = {lo, hi}; return __builtin_bit_cast(unsigned, __builtin_convertvector(v, bf16x2_n)); }
typedef float f32x2 __attribute__((ext_vector_type(2)));
template <class Epi, class Sched, bool STAMP = false>
__device__ __forceinline__ void gemm_phase(PG8_LAS unsigned char* lds, const Gemm g, const Sched& S, const Epi& E, unsigned long long* stamps, const int tid) {
    const int wid = __builtin_amdgcn_readfirstlane(tid >> 6), lane = tid & 63, wr = wid >> 2, wc = wid & 3, fr = lane & 15, fq = lane >> 4;
    const int K = g.K, nt = K / BK;
    int ts_lo = 0, ts_hi = 0, nts = 0; const unsigned long long rt_entry = STAMP ? (unsigned long long)wall_clock64() : 0ull;
#define PG8_STAMP() do { if (STAMP && wid == 0 && nts < 64) { const unsigned long long _c = (unsigned long long)clock64(); \
        ts_lo = (lane == nts) ? (int)(unsigned)_c : ts_lo; ts_hi = (lane == nts) ? (int)(unsigned)(_c >> 32) : ts_hi; ++nts; } } while (0)
    PG8_STAMP();
    unsigned voffA[2], voffB[2];
#pragma unroll
    for (int i = 0; i < 2; ++i) { int R, C; stage_rc(tid * 16 + i * 8192, R, C); const int Rb = Epi::PERM ? ((R & ~31) + perm32(R & 31)) : R;
        voffA[i] = (unsigned)(R * K + C) * 2u; voffB[i] = (unsigned)(Rb * K + C) * 2u; }
    const size_t kstep = (size_t)(BK * 2);
    const size_t hstep = (size_t)HALF * K * 2;
    const size_t tstep = 2 * hstep;
    const unsigned ldsw = (unsigned)wid * 1024u;
    const int aoff = lds_byte(wr * 64 + fr, fq * 8), boff = lds_byte(wc * 32 + fr, fq * 8);
#define PG8_SA(b, h) (((b) * 2 + (h)) * HTB)
#define PG8_SB(b, h) ((4 + (b) * 2 + (h)) * HTB)
#define PG8_STAGE(bufoff, gbase, voff) do { _Pragma("unroll") for (int _i = 0; _i < 2; ++_i) \
        __builtin_amdgcn_global_load_lds((const unsigned*)((const char*)(gbase) + (voff)[_i]), (PG8_LAS unsigned*)(lds + (bufoff) + ldsw + _i * 8192), 16, 0, 0); } while (0)
#define PG8_LDA(dst, b, h) do { _Pragma("unroll") for (int m = 0; m < 4; ++m) _Pragma("unroll") for (int k = 0; k < 2; ++k) dst[m][k] = *(const PG8_LAS bf16x8*)(lds + PG8_SA(b, h) + aoff + m * 2048 + k * 1024); } while (0)
#define PG8_LDB(dst, b, h) do { _Pragma("unroll") for (int n = 0; n < 2; ++n) _Pragma("unroll") for (int k = 0; k < 2; ++k) dst[n][k] = *(const PG8_LAS bf16x8*)(lds + PG8_SB(b, h) + boff + n * 2048 + k * 1024); } while (0)
#define PG8_MMA(ai, bj, At, Bt) do { __builtin_amdgcn_s_setprio(1); _Pragma("unroll") for (int m = 0; m < 4; ++m) _Pragma("unroll") for (int n = 0; n < 2; ++n) _Pragma("unroll") for (int k = 0; k < 2; ++k) \
        acc[ai][bj][m][n] = __builtin_amdgcn_mfma_f32_16x16x32_bf16(Bt[n][k], At[m][k], acc[ai][bj][m][n], 0, 0, 0); __builtin_amdgcn_s_setprio(0); } while (0)
#define PG8_WAIT_V(n) asm volatile("s_waitcnt vmcnt(" #n ")" ::: "memory")
#define PG8_WAIT_L(n) asm volatile("s_waitcnt lgkmcnt(" #n ")" ::: "memory")
#define PG8_BAR __builtin_amdgcn_s_barrier()
#define PG8_SCHED __builtin_amdgcn_sched_barrier(0)
    Unit cur, nxt; int ui = 0;
    if (!S.next(0, cur)) return;
    f32x4 acc[2][2][4][2];
#pragma unroll
    for (int a = 0; a < 2; ++a)
#pragma unroll
        for (int b = 0; b < 2; ++b)
#pragma unroll
            for (int m = 0; m < 4; ++m)
#pragma unroll
                for (int n = 0; n < 2; ++n) acc[a][b][m][n] = (f32x4){0.f, 0.f, 0.f, 0.f};
    bf16x8 At[4][2], B0[2][2], B1[2][2];
    const char* cA = (const char*)g.A + (size_t)cur.pm * tstep; const char* cB = (const char*)g.Bt + (size_t)cur.pn * tstep;
    S.a_ready(cur);
    PG8_STAGE(PG8_SB(0, 0), cB, voffB); PG8_STAGE(PG8_SA(0, 0), cA, voffA); PG8_STAGE(PG8_SB(0, 1), cB + hstep, voffB); PG8_STAGE(PG8_SA(0, 1), cA + hstep, voffA);
    if (wr == 1) PG8_BAR;
    PG8_WAIT_V(4); PG8_BAR;
    PG8_STAGE(PG8_SB(1, 0), cB + kstep, voffB); PG8_STAGE(PG8_SA(1, 0), cA + kstep, voffA); PG8_STAGE(PG8_SB(1, 1), cB + hstep + kstep, voffB);
    PG8_WAIT_V(6); PG8_BAR;
    PG8_STAMP();
    for (;;) {
        const bool has_next = S.next(ui + 1, nxt);
        const char* nA = has_next ? (const char*)g.A + (size_t)nxt.pm * tstep : cA; const char* nB = has_next ? (const char*)g.Bt + (size_t)nxt.pn * tstep : cB;
        for (int t = 0; t < nt; t += 2) {
            const bool last = (t == nt - 2);
            const char* a1 = cA + (size_t)(t + 1) * kstep;
            const char* a2 = last ? nA : cA + (size_t)(t + 2) * kstep; const char* b2 = last ? nB : cB + (size_t)(t + 2) * kstep;
            const char* a3 = a2 + kstep; const char* b3 = b2 + kstep;
            if (last && has_next) S.a_ready(nxt);
            PG8_LDB(B0, 0, 0); PG8_SCHED; PG8_LDA(At, 0, 0); PG8_STAGE(PG8_SA(1, 1), a1 + hstep, voffA);
            PG8_WAIT_L(8); PG8_BAR; PG8_WAIT_L(0); PG8_MMA(0, 0, At, B0); PG8_BAR; PG8_SCHED;
            PG8_LDB(B1, 0, 1); PG8_STAGE(PG8_SB(0, 0), b2, voffB);
            PG8_BAR; PG8_WAIT_L(0); PG8_MMA(0, 1, At, B1); PG8_BAR;
            PG8_LDA(At, 0, 1); PG8_STAGE(PG8_SA(0, 0), a2, voffA);
            PG8_BAR; PG8_WAIT_L(0); PG8_MMA(1, 0, At, B0); PG8_BAR; PG8_SCHED;
            PG8_STAGE(PG8_SB(0, 1), b2 + hstep, voffB);
            PG8_WAIT_V(6); PG8_BAR; PG8_MMA(1, 1, At, B1); PG8_BAR;
            PG8_LDB(B0, 1, 0); PG8_SCHED; PG8_LDA(At, 1, 0); PG8_STAGE(PG8_SA(0, 1), a2 + hstep, voffA);
            PG8_WAIT_L(8); PG8_BAR; PG8_WAIT_L(0); PG8_MMA(0, 0, At, B0); PG8_BAR; PG8_SCHED;
            PG8_LDB(B1, 1, 1); PG8_STAGE(PG8_SB(1, 0), b3, voffB);
            PG8_BAR; PG8_WAIT_L(0); PG8_MMA(0, 1, At, B1); PG8_BAR;
            PG8_LDA(At, 1, 1); PG8_STAGE(PG8_SA(1, 0), a3, voffA);
            PG8_BAR; PG8_WAIT_L(0); PG8_MMA(1, 0, At, B0); PG8_BAR; PG8_SCHED;
            PG8_STAGE(PG8_SB(1, 1), b3 + hstep, voffB);
            PG8_WAIT_V(6); PG8_BAR; PG8_MMA(1, 1, At, B1); PG8_BAR;
        }
        PG8_STAMP();
        if constexpr (!Epi::AFTER_DRAIN) { E(acc, cur, wr, wc, fr, fq); S.done(cur); }
        PG8_STAMP();
        if (!has_next) break;
#pragma unroll
        for (int a = 0; a < 2; ++a)
#pragma unroll
            for (int b = 0; b < 2; ++b)
#pragma unroll
                for (int m = 0; m < 4; ++m)
#pragma unroll
                    for (int n = 0; n < 2; ++n) acc[a][b][m][n] = (f32x4){0.f, 0.f, 0.f, 0.f};
        cur = nxt; cA = nA; cB = nB; ++ui;
    }
    PG8_WAIT_V(0);
    if (wr == 0) PG8_BAR;
    PG8_BAR;
    if constexpr (Epi::AFTER_DRAIN) { E.fused(acc, cur, wr, wc, fr, fq, lds, wid, lane); S.done(cur); }
    PG8_STAMP();
    if (STAMP && wid == 0) { stamps[lane] = lane < nts ? (((unsigned long long)(unsigned)ts_hi << 32) | (unsigned)ts_lo) : 0ull;
        if (lane == 62) stamps[62] = rt_entry; if (lane == 63) stamps[63] = (unsigned long long)wall_clock64(); }
#undef PG8_STAMP
#undef PG8_SA
#undef PG8_SB
#undef PG8_STAGE
#undef PG8_LDA
#undef PG8_LDB
#undef PG8_MMA
#undef PG8_WAIT_V
#undef PG8_WAIT_L
#undef PG8_BAR
#undef PG8_SCHED
}
}

using pg8::bf16_t; using pg8::bf16x8; using pg8::f32x4; using pg8::u32x4; using pg8::cvt_pk_bf16;
#define LAS __attribute__((address_space(3)))
typedef unsigned u32x2 __attribute__((ext_vector_type(2)));

constexpr int D = 1024, MLAT = 65536, MCTX = 2048, MTOT = 67584, NIN = 3248, NINP = 3328, DFF = 2816;
constexpr int NCH = 132;
constexpr int SA_SZ = 97 * 96, SC_SZ = 96 * 48;
constexpr int LDS_BYTES = 147456;
constexpr float RMS_EPS = 1e-6f;

constexpr size_t MiB = 1u << 20;
constexpr size_t WS_MOD = 0, WS_DECA = 1 * MiB, WS_DECC = 2 * MiB, WS_WIN = 4 * MiB, WS_WOUT = 30 * MiB, WS_WFI = 38 * MiB, WS_WFO = 82 * MiB,
                 WS_XCTX = 104 * MiB, WS_GATES = 112 * MiB, WS_HY = 125 * MiB, WS_PROJ = 257 * MiB, WS_STA = 686 * MiB, WS_STC = 837 * MiB, WS_END = 912 * MiB;

struct Params { const float* in[22]; float* out; unsigned char* ws; int ph_lo, ph_hi; };

__device__ __forceinline__ float bflo(unsigned u) { return __uint_as_float(u << 16); }
__device__ __forceinline__ float bfhi(unsigned u) { return __uint_as_float(u & 0xffff0000u); }
__device__ __forceinline__ void unpack8(const uint4 v, float (&f)[8]) { f[0] = bflo(v.x); f[1] = bfhi(v.x); f[2] = bflo(v.y); f[3] = bfhi(v.y); f[4] = bflo(v.z); f[5] = bfhi(v.z); f[6] = bflo(v.w); f[7] = bfhi(v.w); }
__device__ __forceinline__ void unpack4(const uint2 v, float (&f)[4]) { f[0] = bflo(v.x); f[1] = bfhi(v.x); f[2] = bflo(v.y); f[3] = bfhi(v.y); }
__device__ __forceinline__ uint4 pack8(const float (&f)[8]) { uint4 r; r.x = cvt_pk_bf16(f[0], f[1]); r.y = cvt_pk_bf16(f[2], f[3]); r.z = cvt_pk_bf16(f[4], f[5]); r.w = cvt_pk_bf16(f[6], f[7]); return r; }
__device__ __forceinline__ bf16_t f2bf1(float f) { return (bf16_t)(cvt_pk_bf16(f, 0.f) & 0xffffu); }
__device__ __forceinline__ float sigmoid_(float x) { return __fdividef(1.f, 1.f + __expf(-x)); }
__device__ __forceinline__ float silu_(float x) { return x * sigmoid_(x); }
__device__ __forceinline__ float logsigmoid_(float x) { return fminf(x, 0.f) - __logf(1.f + __expf(-fabsf(x))); }
__device__ __forceinline__ float gelu_(float x) { const float u = 0.7978845608f * (x + 0.044715f * x * x * x); const float t = 1.f - __fdividef(2.f, 1.f + __expf(2.f * u)); return 0.5f * x * (1.f + t); }
__device__ __forceinline__ float wave_sum(float v) {
#pragma unroll
    for (int o = 1; o < 64; o <<= 1) v += __shfl_xor(v, o);
    return v;
}
__device__ __forceinline__ float wave_incl_scan(float v, int lane) {
#pragma unroll
    for (int o = 1; o < 64; o <<= 1) { const float t = __shfl_up(v, o); if (lane >= o) v += t; }
    return v;
}
#define MFMA16(a, b, c) __builtin_amdgcn_mfma_f32_16x16x32_bf16((a), (b), (c), 0, 0, 0)
#define LDSFRAG(ptr) (*(const LAS bf16x8*)(ptr))

__device__ __forceinline__ void transpose_item(const float* W, int K, int N, bf16_t* WT, int row0, LAS float* scr, int k0, int n0, int lane) {
#pragma unroll 8
    for (int i = 0; i < 32; ++i) { const int kk = 2 * i + (lane >> 5), n = n0 + (lane & 31); scr[kk * 33 + (lane & 31)] = (n < N) ? W[(size_t)(k0 + kk) * N + n] : 0.f; }
    asm volatile("s_waitcnt lgkmcnt(0)" ::: "memory");
    const int c = lane & 7;
#pragma unroll
    for (int j = 0; j < 4; ++j) { const int n = (lane >> 3) + 8 * j; const LAS float* s = scr + (8 * c) * 33 + n;
        u32x4 o; o.x = cvt_pk_bf16(s[0 * 33], s[1 * 33]); o.y = cvt_pk_bf16(s[2 * 33], s[3 * 33]); o.z = cvt_pk_bf16(s[4 * 33], s[5 * 33]); o.w = cvt_pk_bf16(s[6 * 33], s[7 * 33]);
        *(u32x4*)(WT + (size_t)(row0 + n) * K + k0 + 8 * c) = o; }
    asm volatile("s_waitcnt lgkmcnt(0)" ::: "memory");
}

__device__ __forceinline__ void phase_prologue(const Params& P, LAS unsigned char* lds, int tid, int wave, int lane) {
    const int G = gridDim.x;
    float* MOD = (float*)(P.ws + WS_MOD);
    if ((int)blockIdx.x < 384) {
        LAS float* sv = (LAS float*)lds; LAS float* red = (LAS float*)(lds + 36864);
        for (int i = tid; i < 9 * 1024; i += 512) { const float c = (i < 8192) ? P.in[1][i] : P.in[3][i - 8192]; sv[i] = silu_(c); }
        __syncthreads();
        for (int item = blockIdx.x; item < 384; item += G) {
            const int l = item / 96, nb = item % 96, n = nb * 64 + lane;
            const float* wa = P.in[6] + (size_t)l * 1024 * 6144 + n;
            float acc[9];
#pragma unroll
            for (int r = 0; r < 9; ++r) acc[r] = 0.f;
#pragma unroll 4
            for (int k = wave * 128; k < wave * 128 + 128; ++k) { const float wv = wa[(size_t)k * 6144];
#pragma unroll
                for (int r = 0; r < 9; ++r) acc[r] += sv[r * 1024 + k] * wv; }
#pragma unroll
            for (int r = 0; r < 9; ++r) red[(wave * 9 + r) * 64 + lane] = acc[r];
            __syncthreads();
            for (int idx = tid; idx < 576; idx += 512) { const int r = idx >> 6, ln = idx & 63; float s = P.in[7][l * 6144 + nb * 64 + ln];
#pragma unroll
                for (int w = 0; w < 8; ++w) s += red[(w * 9 + r) * 64 + ln];
                MOD[(size_t)(l * 9 + r) * 6144 + nb * 64 + ln] = s; }
            __syncthreads();
        }
    }
    __syncthreads();
    LAS float* scr = (LAS float*)(lds + wave * 8704);
    const int gw = blockIdx.x * 8 + wave, NGW = G * 8;
    for (int it = gw; it < 4 * 6400; it += NGW) {
        const int l = it / 6400; int r = it % 6400;
        if (r < 1664) { const int kb = r / 104, nb = r % 104;
            transpose_item(P.in[8] + (size_t)l * 1024 * NIN, 1024, NIN, (bf16_t*)(P.ws + WS_WIN) + (size_t)l * NINP * 1024, nb * 32, scr, kb * 64, nb * 32, lane); continue; }
        r -= 1664;
        if (r < 512) { const int kb = r / 32, nb = r % 32;
            transpose_item(P.in[18] + (size_t)l * 1024 * 1024, 1024, 1024, (bf16_t*)(P.ws + WS_WOUT) + (size_t)l * 1024 * 1024, nb * 32, scr, kb * 64, nb * 32, lane); continue; }
        r -= 512;
        if (r < 2816) { const int kb = r / 176, nb = r % 176, n0 = nb * 32;
            const int row0 = (n0 < DFF) ? (n0 / 128) * 256 + (n0 % 128) : ((n0 - DFF) / 128) * 256 + 128 + ((n0 - DFF) % 128);
            transpose_item(P.in[19] + (size_t)l * 1024 * 5632, 1024, 5632, (bf16_t*)(P.ws + WS_WFI) + (size_t)l * 5632 * 1024, row0 - n0 + n0  , scr, kb * 64, n0, lane); continue; }
        r -= 2816;
        { const int kb = r / 32, nb = r % 32;
            transpose_item(P.in[20] + (size_t)l * DFF * 1024, DFF, 1024, (bf16_t*)(P.ws + WS_WFO) + (size_t)l * 1024 * DFF, nb * 32, scr, kb * 64, nb * 32, lane); }
    }
}

__device__ __forceinline__ void phase_norm(const float* xl, const float* xc, float* cl, float* cc, const float* g, const float* mod  , int ish, int isc, bf16_t* H, int M, int wave, int lane) {
    const int gw = blockIdx.x * 8 + wave, NGW = gridDim.x * 8;
    for (int row = gw; row < M; row += NGW) {
        const float* src = (row < MLAT) ? xl + (size_t)row * D : xc + (size_t)(row - MLAT) * D;
        const int r = (row < MLAT) ? (row >> 13) : 8;
        f32x4 v[4]; float ss = 0.f;
#pragma unroll
        for (int j = 0; j < 4; ++j) { v[j] = *(const f32x4*)(src + 4 * (lane + 64 * j)); ss += (v[j][0] * v[j][0] + v[j][1] * v[j][1]) + (v[j][2] * v[j][2] + v[j][3] * v[j][3]); }
        const float rstd = rsqrtf(wave_sum(ss) * (1.f / D) + RMS_EPS);
        if (cl) { float* dst = (row < MLAT) ? cl + (size_t)row * D : cc + (size_t)(row - MLAT) * D;
#pragma unroll
            for (int j = 0; j < 4; ++j) *(f32x4*)(dst + 4 * (lane + 64 * j)) = v[j]; }
        const float* mr = mod + (size_t)r * 6144;
#pragma unroll
        for (int j = 0; j < 4; ++j) { const int col = 4 * (lane + 64 * j);
            const f32x4 g4 = *(const f32x4*)(g + col), sc = *(const f32x4*)(mr + isc * 1024 + col), sh = *(const f32x4*)(mr + ish * 1024 + col);
            const f32x4 y = (v[j] * rstd * g4) * (sc + 1.f) + sh;
            u32x2 o; o.x = cvt_pk_bf16(y[0], y[1]); o.y = cvt_pk_bf16(y[2], y[3]);
            *(u32x2*)(H + (size_t)row * D + col) = o; }
    }
}
__device__ __forceinline__ void phase_final(float* x, const float* g, int wave, int lane) {
    const int gw = blockIdx.x * 8 + wave, NGW = gridDim.x * 8;
    for (int row = gw; row < MLAT; row += NGW) {
        float* src = x + (size_t)row * D; f32x4 v[4]; float ss = 0.f;
#pragma unroll
        for (int j = 0; j < 4; ++j) { v[j] = *(const f32x4*)(src + 4 * (lane + 64 * j)); ss += (v[j][0] * v[j][0] + v[j][1] * v[j][1]) + (v[j][2] * v[j][2] + v[j][3] * v[j][3]); }
        const float rstd = rsqrtf(wave_sum(ss) * (1.f / D) + RMS_EPS);
#pragma unroll
        for (int j = 0; j < 4; ++j) { const int col = 4 * (lane + 64 * j); f32x4 o = v[j] * rstd * *(const f32x4*)(g + col);
#ifdef DBG_SANITIZE
            for (int q = 0; q < 4; ++q) if (!(fabsf(o[q]) < 1e30f)) o[q] = 777.f;
#endif
            *(f32x4*)(src + col) = o; }
    }
}

struct EpiProj {
    static constexpr bool PERM = true, AFTER_DRAIN = false;
    bf16_t* O; float* gates; int colmajor;
    __device__ __forceinline__ void operator()(const f32x4 (&acc)[2][2][4][2], const pg8::Unit& u, int wr, int wc, int fr, int fq) const {
        const int col0 = u.pn * 256 + wc * 32 + 8 * fq; const bool gt = (u.pn == 6) || (u.pn == 12);
#pragma unroll
        for (int ai = 0; ai < 2; ++ai)
#pragma unroll
            for (int m = 0; m < 4; ++m) { const int r = u.pm * 256 + ai * 128 + wr * 64 + m * 16 + fr; int dr = r;
                if (colmajor && r < MLAT) { const int rho = r & 8191; dr = (r & ~8191) + (rho & 63) * 128 + (rho >> 6); }
                bf16_t* rowp = O + (size_t)dr * NINP + col0;
#pragma unroll
                for (int bj = 0; bj < 2; ++bj) { const f32x4 v0 = acc[ai][bj][m][0], v1 = acc[ai][bj][m][1];
                    u32x4 w; w.x = cvt_pk_bf16(v0[0], v0[1]); w.y = cvt_pk_bf16(v0[2], v0[3]); w.z = cvt_pk_bf16(v1[0], v1[1]); w.w = cvt_pk_bf16(v1[2], v1[3]);
                    *(u32x4*)(rowp + bj * 128) = w;
                    if (gt) { const int c = col0 + bj * 128;
                        if (c >= 1536 && c < 1552) { float* gp = gates + (size_t)dr * 48 + (c - 1536); *(f32x4*)gp = v0; *(f32x4*)(gp + 4) = v1; }
                        else if (c >= 3216 && c < 3248) { float* gp = gates + (size_t)dr * 48 + 16 + (c - 3216); *(f32x4*)gp = v0; *(f32x4*)(gp + 4) = v1; } } } }
    }
};
struct EpiRes {
    static constexpr bool PERM = false, AFTER_DRAIN = false;
    float* xlat; float* xctx; const float* gmod; int colmajor;
    __device__ __forceinline__ void operator()(const f32x4 (&acc)[2][2][4][2], const pg8::Unit& u, int wr, int wc, int fr, int fq) const {
        const int col0 = u.pn * 256 + wc * 32 + 4 * fq; const int rmod = (u.pm < 256) ? (u.pm >> 5) : 8;
        f32x4 gv[2][2];
#pragma unroll
        for (int bj = 0; bj < 2; ++bj)
#pragma unroll
            for (int n = 0; n < 2; ++n) gv[bj][n] = *(const f32x4*)(gmod + (size_t)rmod * 6144 + col0 + bj * 128 + n * 16);
#pragma unroll
        for (int ai = 0; ai < 2; ++ai)
#pragma unroll
            for (int m = 0; m < 4; ++m) { const int r = u.pm * 256 + ai * 128 + wr * 64 + m * 16 + fr; float* rowp;
                if (r < MLAT) { int dr = r; if (colmajor) { const int tp = r & 8191; dr = (r & ~8191) + (tp & 127) * 64 + (tp >> 7); } rowp = xlat + (size_t)dr * D; }
                else rowp = xctx + (size_t)(r - MLAT) * D;
                rowp += col0;
#pragma unroll
                for (int bj = 0; bj < 2; ++bj)
#pragma unroll
                    for (int n = 0; n < 2; ++n) { f32x4* p = (f32x4*)(rowp + bj * 128 + n * 16); *p = *p + gv[bj][n] * acc[ai][bj][m][n]; } }
    }
};
struct EpiFfn {
    static constexpr bool PERM = true, AFTER_DRAIN = false;
    bf16_t* Hd;
    __device__ __forceinline__ void operator()(const f32x4 (&acc)[2][2][4][2], const pg8::Unit& u, int wr, int wc, int fr, int fq) const {
        const int col0 = u.pn * 128 + wc * 32 + 8 * fq;
#pragma unroll
        for (int ai = 0; ai < 2; ++ai)
#pragma unroll
            for (int m = 0; m < 4; ++m) { const int r = u.pm * 256 + ai * 128 + wr * 64 + m * 16 + fr;
                const f32x4 g0 = acc[ai][0][m][0], g1 = acc[ai][0][m][1], u0 = acc[ai][1][m][0], u1 = acc[ai][1][m][1];
                u32x4 w; w.x = cvt_pk_bf16(silu_(g0[0]) * u0[0], silu_(g0[1]) * u0[1]); w.y = cvt_pk_bf16(silu_(g0[2]) * u0[2], silu_(g0[3]) * u0[3]);
                w.z = cvt_pk_bf16(silu_(g1[0]) * u1[0], silu_(g1[1]) * u1[1]); w.w = cvt_pk_bf16(silu_(g1[2]) * u1[2], silu_(g1[3]) * u1[3]);
                *(u32x4*)(Hd + (size_t)r * DFF + col0) = w; }
    }
};

struct UnitGeo { int rowbase, T, t0; };
__device__ __forceinline__ UnitGeo unit_geo(int b, int ci) { UnitGeo g; if (ci < 4) { g.rowbase = MLAT + b * 256 + ci * 64; g.T = 256; g.t0 = ci * 64; } else { g.rowbase = b * 8192 + (ci - 4) * 64; g.T = 8192; g.t0 = (ci - 4) * 64; } return g; }

__device__ __forceinline__ void mlstm_gates(const float* GATES, const float* gbias, int rowbase, int h, int lane, LAS float* GT) {
    const float* gr = GATES + (size_t)(rowbase + lane) * 48;
    const float i_f = gr[h] + gbias[h], f_f = gr[4 + h] + gbias[4 + h], i_b = gr[8 + h] + gbias[8 + h], f_b = gr[12 + h] + gbias[12 + h];
    const float lf = logsigmoid_(f_f), lb = logsigmoid_(f_b);
    const float bf = wave_incl_scan(lf, lane), ib_incl = wave_incl_scan(lb, lane);
    const float tot = __shfl(ib_incl, 63), rb = tot - ib_incl + lb;
    GT[lane] = bf; GT[64 + lane] = i_f - bf; GT[128 + lane] = rb; GT[192 + lane] = i_b - rb;
}
__device__ __forceinline__ void conv_silu8(const bf16_t* p, bool has_prev, bool has_next, const float* cw  , float scale, float (&y)[8]) {
    float x0[8], x1[8], x2[8];
    unpack8(*(const uint4*)p, x1);
    if (has_prev) unpack8(*(const uint4*)(p - NINP), x0); else {
#pragma unroll
        for (int j = 0; j < 8; ++j) x0[j] = 0.f; }
    if (has_next) unpack8(*(const uint4*)(p + NINP), x2); else {
#pragma unroll
        for (int j = 0; j < 8; ++j) x2[j] = 0.f; }
    const f32x4 w0a = *(const f32x4*)(cw), w0b = *(const f32x4*)(cw + 4), w1a = *(const f32x4*)(cw + 768), w1b = *(const f32x4*)(cw + 772), w2a = *(const f32x4*)(cw + 1536), w2b = *(const f32x4*)(cw + 1540);
#pragma unroll
    for (int j = 0; j < 8; ++j) { const float w0 = j < 4 ? w0a[j & 3] : w0b[j & 3], w1 = j < 4 ? w1a[j & 3] : w1b[j & 3], w2 = j < 4 ? w2a[j & 3] : w2b[j & 3];
        y[j] = silu_(w0 * x0[j] + w1 * x1[j] + w2 * x2[j]) * scale; }
}

__device__ __forceinline__ void mlstm_p1_unit(const Params& P, LAS unsigned char* lds, int l, int b, int h, int ci, int tid, int wave, int lane) {
    const bf16_t* PROJ = (const bf16_t*)(P.ws + WS_PROJ); const float* GATES = (const float*)(P.ws + WS_GATES);
    bf16_t* STA = (bf16_t*)(P.ws + WS_STA); float* DECA = (float*)(P.ws + WS_DECA);
    LAS bf16_t* KT = (LAS bf16_t*)lds; LAS bf16_t* VTw = (LAS bf16_t*)(lds + 13824); LAS float* GT = (LAS float*)(lds + 46080); LAS float* WF = (LAS float*)(lds + 47104);
    const UnitGeo ug = unit_geo(b, ci);
    const float* conv = P.in[9] + l * 3 * 768; const float* gbias = P.in[10] + l * 16;
    const int sidx0 = (b * 4 + h) * 2;
    __syncthreads();
    if (wave == 0) {
        mlstm_gates(GATES, gbias, ug.rowbase, h, lane, GT);
        asm volatile("s_waitcnt lgkmcnt(0)" ::: "memory");
        const float bfl = GT[63], rb0 = GT[128];
        WF[lane] = __expf(bfl + GT[64 + lane]); WF[64 + lane] = __expf(rb0 + GT[192 + lane]);
        if (lane == 0) { DECA[(sidx0 + 0) * NCH + ci] = __expf(bfl); DECA[(sidx0 + 1) * NCH + ci] = __expf(rb0); }
    }
    __syncthreads();
    for (int it = tid; it < 768; it += 512) { const int t = it / 12, v = it % 12; const int tt = ug.t0 + t;
        float y[8]; conv_silu8(PROJ + (size_t)(ug.rowbase + t) * NINP + 384 + h * 96 + v * 8, tt > 0, tt < ug.T - 1, conv + 384 + h * 96 + v * 8, 1.f, y);
#pragma unroll
        for (int j = 0; j < 8; ++j) KT[(v * 8 + j) * 72 + t] = f2bf1(y[j]);
        float x[8]; unpack8(*(const uint4*)(PROJ + (size_t)(ug.rowbase + t) * NINP + 768 + h * 96 + v * 8), x);
        const float wf = WF[t], wb = WF[64 + t];
#pragma unroll
        for (int j = 0; j < 8; ++j) { VTw[(v * 8 + j) * 72 + t] = f2bf1(x[j] * wf); VTw[8064 + (v * 8 + j) * 72 + t] = f2bf1(x[j] * wb); }
    }
    for (int it = tid; it < 2 * 16 * 64; it += 512) { const int dir = it >> 10, e = 96 + ((it >> 6) & 15), t = it & 63;
        VTw[dir * 8064 + e * 72 + t] = (e == 96) ? f2bf1(WF[dir * 64 + t]) : (bf16_t)0; }
    __syncthreads();
#ifdef DBG_P1
    { unsigned f = 0;
      for (int i = tid; i < 96 * 64; i += 512) { const int r = i >> 6, c = i & 63; const float v = __uint_as_float((unsigned)KT[r * 72 + c] << 16); if (!(fabsf(v) < 1e6f)) f |= 1u; }
      for (int i = tid; i < 2 * 112 * 64; i += 512) { const int dd = i / 7168, r = (i % 7168) >> 6, c = i & 63; const float v = __uint_as_float((unsigned)VTw[dd * 8064 + r * 72 + c] << 16); if (!(fabsf(v) < 1e6f)) f |= (r < 96 ? 2u : 4u); }
      if (tid < 128) { const float v = WF[tid]; if (!(fabsf(v) < 1e6f)) f |= 8u; }
      if (tid < 256) { const float v = GT[tid]; if (!(fabsf(v) < 1e6f)) f |= 32u; }
      if (f) atomicOr((unsigned*)(P.ws + 900000), f); }
#endif
    const int dir = wave >> 2, l15 = lane & 15, quad = lane >> 4;
    bf16_t* dst = STA + ((size_t)(sidx0 + dir) * NCH + ci) * SA_SZ;
#pragma unroll
    for (int ei = 0; ei < 2; ++ei) { const int et = (wave & 3) + 4 * ei;
        if (et < 7) {
            bf16x8 vf[2];
#pragma unroll
            for (int ks = 0; ks < 2; ++ks) vf[ks] = LDSFRAG(VTw + dir * 8064 + (16 * et + l15) * 72 + 32 * ks + 8 * quad);
#pragma unroll
            for (int dt = 0; dt < 6; ++dt) { f32x4 acc = {0.f, 0.f, 0.f, 0.f};
#pragma unroll
                for (int ks = 0; ks < 2; ++ks) acc = MFMA16(LDSFRAG(KT + (16 * dt + l15) * 72 + 32 * ks + 8 * quad), vf[ks], acc);
                const int e = 16 * et + l15;
#ifdef DBG_P1
                if (!(fabsf(acc[0]) < 1e6f) || !(fabsf(acc[1]) < 1e6f) || !(fabsf(acc[2]) < 1e6f) || !(fabsf(acc[3]) < 1e6f)) atomicOr((unsigned*)(P.ws + 900000), 16u);
#endif
                if (e <= 96) { u32x2 o; o.x = cvt_pk_bf16(acc[0], acc[1]); o.y = cvt_pk_bf16(acc[2], acc[3]); *(u32x2*)(dst + e * 96 + 16 * dt + 4 * quad) = o; } }
        } }
}

__device__ __forceinline__ void mlstm_p3_unit(const Params& P, LAS unsigned char* lds, int l, int b, int h, int ci, int tid, int wave, int lane) {
    const bf16_t* PROJ = (const bf16_t*)(P.ws + WS_PROJ); const float* GATES = (const float*)(P.ws + WS_GATES);
    const bf16_t* STA = (const bf16_t*)(P.ws + WS_STA); bf16_t* Y = (bf16_t*)(P.ws + WS_HY);
    LAS bf16_t* Qs = (LAS bf16_t*)lds; LAS bf16_t* Ks = (LAS bf16_t*)(lds + 13312); LAS bf16_t* VT = (LAS bf16_t*)(lds + 26624); LAS bf16_t* Cs = (LAS bf16_t*)(lds + 42752);
    LAS bf16_t* Sw = (LAS bf16_t*)(lds + 89344); LAS float* HB = (LAS float*)(lds + 107776); LAS float* GT = (LAS float*)(lds + 133376);
    const UnitGeo ug = unit_geo(b, ci);
    const float* conv = P.in[9] + l * 3 * 768; const float* gbias = P.in[10] + l * 16; const float* ng = P.in[11] + l * 384 + h * 96;
    const int sidx0 = (b * 4 + h) * 2;
    __syncthreads();
    if (wave == 0) mlstm_gates(GATES, gbias, ug.rowbase, h, lane, GT);
    for (int it = tid; it < 1536; it += 512) { const int which = it / 768, rem = it % 768, t = rem / 12, v = rem % 12; const int tt = ug.t0 + t;
        float y[8]; conv_silu8(PROJ + (size_t)(ug.rowbase + t) * NINP + which * 384 + h * 96 + v * 8, tt > 0, tt < ug.T - 1, conv + which * 384 + h * 96 + v * 8, which ? 1.f : 0.10206207262f, y);
        *(uint4*)((which ? Ks : Qs) + t * 104 + v * 8) = pack8(y); }
    for (int it = tid; it < 768; it += 512) { const int t = it / 12, v = it % 12;
        const uint4 raw = *(const uint4*)(PROJ + (size_t)(ug.rowbase + t) * NINP + 768 + h * 96 + v * 8);
        const unsigned w4[4] = {raw.x, raw.y, raw.z, raw.w};
#pragma unroll
        for (int j = 0; j < 8; ++j) VT[(v * 8 + j) * 72 + t] = (bf16_t)((j & 1) ? (w4[j >> 1] >> 16) : (w4[j >> 1] & 0xffffu)); }
    for (int it = tid; it < 16 * 64; it += 512) { const int e = 96 + (it >> 6), t = it & 63; VT[e * 72 + t] = (e == 96) ? (bf16_t)0x3f80 : (bf16_t)0; }
    for (int it = tid; it < 2 * 112 * 12; it += 512) { const int dir = it / 1344, rem = it % 1344, e = rem / 12, v = rem % 12;
        uint4 val = {0u, 0u, 0u, 0u};
        if (e <= 96) val = *(const uint4*)(STA + ((size_t)(sidx0 + dir) * NCH + ci) * SA_SZ + e * 96 + v * 8);
        *(uint4*)(Cs + dir * 11648 + e * 104 + v * 8) = val; }
    __syncthreads();
    const int mt = wave & 3, dir = wave >> 2, l15 = lane & 15, quad = lane >> 4, t = 16 * mt + l15;
    bf16x8 qf[3];
#pragma unroll
    for (int ks = 0; ks < 3; ++ks) qf[ks] = LDSFRAG(Qs + t * 104 + 32 * ks + 8 * quad);
    const float bt = dir ? GT[128 + t] : GT[t];
    LAS bf16_t* Swr = Sw + wave * 1152 + l15 * 72;
#pragma unroll
    for (int st = 0; st < 4; ++st) { f32x4 acc = {0.f, 0.f, 0.f, 0.f};
#pragma unroll
        for (int ks = 0; ks < 3; ++ks) acc = MFMA16(LDSFRAG(Ks + (16 * st + l15) * 104 + 32 * ks + 8 * quad), qf[ks], acc);
        float val[4];
#pragma unroll
        for (int j = 0; j < 4; ++j) { const int s = 16 * st + 4 * quad + j; const float gs = dir ? GT[192 + s] : GT[64 + s]; const bool ok = dir ? (s >= t) : (s <= t);
            val[j] = ok ? acc[j] * __expf(bt + gs) : 0.f; }
        u32x2 o; o.x = cvt_pk_bf16(val[0], val[1]); o.y = cvt_pk_bf16(val[2], val[3]); *(LAS u32x2*)(Swr + 16 * st + 4 * quad) = o; }
    asm volatile("s_waitcnt lgkmcnt(0)" ::: "memory");
    f32x4 a1[7], a2[7];
#pragma unroll
    for (int et = 0; et < 7; ++et) { a1[et] = (f32x4){0.f, 0.f, 0.f, 0.f}; a2[et] = (f32x4){0.f, 0.f, 0.f, 0.f}; }
#pragma unroll
    for (int ks = 0; ks < 2; ++ks) { const bf16x8 sf = LDSFRAG(Swr + 32 * ks + 8 * quad);
#pragma unroll
        for (int et = 0; et < 7; ++et) a1[et] = MFMA16(LDSFRAG(VT + (16 * et + l15) * 72 + 32 * ks + 8 * quad), sf, a1[et]); }
#pragma unroll
    for (int ks = 0; ks < 3; ++ks)
#pragma unroll
        for (int et = 0; et < 7; ++et) a2[et] = MFMA16(LDSFRAG(Cs + dir * 11648 + (16 * et + l15) * 104 + 32 * ks + 8 * quad), qf[ks], a2[et]);
    const float inter = __expf(bt);
#pragma unroll
    for (int et = 0; et < 7; ++et) a1[et] = a1[et] + a2[et] * inter;
    const float den = __shfl(a1[6][0], l15);
    const float inv = __fdividef(1.f, fmaxf(fabsf(den), 1.f));
    if (dir == 1) {
#pragma unroll
        for (int et = 0; et < 6; ++et) *(LAS f32x4*)(HB + t * 100 + 16 * et + 4 * quad) = a1[et] * inv;
    }
    __syncthreads();
    if (dir == 0) { float ss = 0.f;
#pragma unroll
        for (int et = 0; et < 6; ++et) { a1[et] = a1[et] * inv + *(const LAS f32x4*)(HB + t * 100 + 16 * et + 4 * quad); ss += (a1[et][0] * a1[et][0] + a1[et][1] * a1[et][1]) + (a1[et][2] * a1[et][2] + a1[et][3] * a1[et][3]); }
        ss += __shfl_xor(ss, 16); ss += __shfl_xor(ss, 32);
        const float r = rsqrtf(ss * (1.f / 96.f) + RMS_EPS);
        const size_t row = (size_t)(ug.rowbase + t);
#pragma unroll
        for (int et = 0; et < 6; ++et) { const int e = 16 * et + 4 * quad; const f32x4 g4 = *(const f32x4*)(ng + e);
            float oa[4]; unpack4(*(const uint2*)(PROJ + row * NINP + 1152 + h * 96 + e), oa);
            u32x2 o; o.x = cvt_pk_bf16(a1[et][0] * r * g4[0] * sigmoid_(oa[0]), a1[et][1] * r * g4[1] * sigmoid_(oa[1])); o.y = cvt_pk_bf16(a1[et][2] * r * g4[2] * sigmoid_(oa[2]), a1[et][3] * r * g4[3] * sigmoid_(oa[3]));
            *(u32x2*)(Y + row * D + h * 96 + e) = o; } }
}

__device__ __forceinline__ void gla_gates(const Params& P, int l, int h, int rowbase, LAS float* LA, int tid, int wave, int lane) {
    const float* GATES = (const float*)(P.ws + WS_GATES);
    const float* wg = P.in[12] + (size_t)l * 2 * 16 * 192 + h * 48; const float* bg = P.in[13] + l * 2 * 192 + h * 48;
    for (int it = tid; it < 6144; it += 512) { const int d = it % 48, t = (it / 48) & 63, dir = it / 3072;
        const float* gr = GATES + (size_t)(rowbase + t) * 48 + 16 + dir * 16; float gk = bg[dir * 192 + d];
#pragma unroll
        for (int r = 0; r < 16; ++r) gk += gr[r] * wg[(dir * 16 + r) * 192 + d];
        LA[(dir * 64 + t) * 48 + d] = logsigmoid_(gk) * 0.0625f; }
    __syncthreads();
    for (int c = wave * 12; c < wave * 12 + 12; ++c) { const int dir = c / 48, d = c % 48; LAS float* p = LA + (dir * 64 + lane) * 48 + d;
        const float v = *p; const float inc = wave_incl_scan(v, lane);
        if (dir == 0) *p = inc; else { const float tot = __shfl(inc, 63); *p = tot - inc + v; } }
    __syncthreads();
}

__device__ __forceinline__ void gla_p1_unit(const Params& P, LAS unsigned char* lds, int l, int b, int h, int ci, int tid, int wave, int lane) {
    const bf16_t* PROJ = (const bf16_t*)(P.ws + WS_PROJ); bf16_t* STC = (bf16_t*)(P.ws + WS_STC); float* DECC = (float*)(P.ws + WS_DECC);
    LAS float* LA = (LAS float*)lds; LAS bf16_t* KH = (LAS bf16_t*)(lds + 24576); LAS bf16_t* VT = (LAS bf16_t*)(lds + 38400);
    const UnitGeo ug = unit_geo(b, ci); const int sidx0 = (b * 4 + h) * 2;
    __syncthreads();
    gla_gates(P, l, h, ug.rowbase, LA, tid, wave, lane);
    if (tid < 96) { const int dir = tid / 48, d = tid % 48; DECC[((size_t)(sidx0 + dir) * NCH + ci) * 48 + d] = __expf(LA[(dir * 64 + (dir ? 0 : 63)) * 48 + d]); }
    for (int it = tid; it < 384; it += 512) { const int s = it / 6, v = it % 6;
        float x[8]; unpack8(*(const uint4*)(PROJ + (size_t)(ug.rowbase + s) * NINP + 2256 + h * 48 + v * 8), x);
#pragma unroll
        for (int j = 0; j < 8; ++j) { const int d = v * 8 + j;
            KH[d * 72 + s] = f2bf1(x[j] * __expf(LA[63 * 48 + d] - LA[s * 48 + d]));
            KH[3456 + d * 72 + s] = f2bf1(x[j] * __expf(LA[64 * 48 + d] - LA[(64 + s) * 48 + d])); } }
    for (int it = tid; it < 768; it += 512) { const int t = it / 12, v = it % 12;
        const uint4 raw = *(const uint4*)(PROJ + (size_t)(ug.rowbase + t) * NINP + 2448 + h * 96 + v * 8);
        const unsigned w4[4] = {raw.x, raw.y, raw.z, raw.w};
#pragma unroll
        for (int j = 0; j < 8; ++j) VT[(v * 8 + j) * 72 + t] = (bf16_t)((j & 1) ? (w4[j >> 1] >> 16) : (w4[j >> 1] & 0xffffu)); }
    __syncthreads();
    const int dir = wave >> 2, l15 = lane & 15, quad = lane >> 4;
    bf16_t* dst = STC + ((size_t)(sidx0 + dir) * NCH + ci) * SC_SZ;
#pragma unroll
    for (int ei = 0; ei < 2; ++ei) { const int et = (wave & 3) + 4 * ei;
        if (et < 6) {
            bf16x8 vf[2];
#pragma unroll
            for (int ks = 0; ks < 2; ++ks) vf[ks] = LDSFRAG(VT + (16 * et + l15) * 72 + 32 * ks + 8 * quad);
#pragma unroll
            for (int dt = 0; dt < 3; ++dt) { f32x4 acc = {0.f, 0.f, 0.f, 0.f};
#pragma unroll
                for (int ks = 0; ks < 2; ++ks) acc = MFMA16(LDSFRAG(KH + dir * 3456 + (16 * dt + l15) * 72 + 32 * ks + 8 * quad), vf[ks], acc);
                u32x2 o; o.x = cvt_pk_bf16(acc[0], acc[1]); o.y = cvt_pk_bf16(acc[2], acc[3]); *(u32x2*)(dst + (16 * et + l15) * 48 + 16 * dt + 4 * quad) = o; }
        } }
}

__device__ __forceinline__ void gla_p3_unit(const Params& P, LAS unsigned char* lds, int l, int b, int h, int ci, int tid, int wave, int lane) {
    const bf16_t* PROJ = (const bf16_t*)(P.ws + WS_PROJ); const bf16_t* STC = (const bf16_t*)(P.ws + WS_STC); bf16_t* Y = (bf16_t*)(P.ws + WS_HY);
    LAS bf16_t* QT = (LAS bf16_t*)lds; LAS bf16_t* KTl = (LAS bf16_t*)(lds + 18432); LAS bf16_t* VT = (LAS bf16_t*)(lds + 36864); LAS bf16_t* STs = (LAS bf16_t*)(lds + 50688);
    LAS bf16_t* Sw = (LAS bf16_t*)(lds + 78336); LAS float* HB = (LAS float*)(lds + 96768); LAS float* LA = (LAS float*)(lds + 96768);
    const UnitGeo ug = unit_geo(b, ci); const int sidx0 = (b * 4 + h) * 2;
    const float* ng = P.in[14] + l * 96;
    __syncthreads();
    gla_gates(P, l, h, ug.rowbase, LA, tid, wave, lane);
    for (int it = tid; it < 768; it += 512) { const int which = it / 384, rem = it % 384, t = rem / 6, v = rem % 6;
        float x[8]; unpack8(*(const uint4*)(PROJ + (size_t)(ug.rowbase + t) * NINP + 2064 + which * 192 + h * 48 + v * 8), x);
        float y0[8], y1[8];
#pragma unroll
        for (int j = 0; j < 8; ++j) { const int d = v * 8 + j; const float a0 = LA[t * 48 + d], a1 = LA[(64 + t) * 48 + d];
            if (which == 0) { y0[j] = x[j] * 0.14433756730f * __expf(a0); y1[j] = x[j] * 0.14433756730f * __expf(a1); } else { y0[j] = x[j] * __expf(-a0); y1[j] = x[j] * __expf(-a1); } }
        LAS bf16_t* dst = which ? KTl : QT;
        *(uint4*)(dst + t * 72 + v * 8) = pack8(y0); *(uint4*)(dst + 4608 + t * 72 + v * 8) = pack8(y1); }
    for (int it = tid; it < 512; it += 512) { const int arr = it >> 7, t = (it >> 1) & 63, v = it & 1;
        const uint4 z = {0u, 0u, 0u, 0u}; *(uint4*)(QT + arr * 4608 + t * 72 + 48 + v * 8) = z; }
    for (int it = tid; it < 768; it += 512) { const int t = it / 12, v = it % 12;
        const uint4 raw = *(const uint4*)(PROJ + (size_t)(ug.rowbase + t) * NINP + 2448 + h * 96 + v * 8);
        const unsigned w4[4] = {raw.x, raw.y, raw.z, raw.w};
#pragma unroll
        for (int j = 0; j < 8; ++j) VT[(v * 8 + j) * 72 + t] = (bf16_t)((j & 1) ? (w4[j >> 1] >> 16) : (w4[j >> 1] & 0xffffu)); }
    for (int it = tid; it < 2 * 96 * 8; it += 512) { const int dir = it / 768, rem = it % 768, e = rem >> 3, v = rem & 7;
        uint4 val = {0u, 0u, 0u, 0u};
        if (v < 6) val = *(const uint4*)(STC + ((size_t)(sidx0 + dir) * NCH + ci) * SC_SZ + e * 48 + v * 8);
        *(uint4*)(STs + dir * 6912 + e * 72 + v * 8) = val; }
    __syncthreads();
    const int mt = wave & 3, dir = wave >> 2, l15 = lane & 15, quad = lane >> 4, t = 16 * mt + l15;
    bf16x8 qf[2];
#pragma unroll
    for (int ks = 0; ks < 2; ++ks) qf[ks] = LDSFRAG(QT + dir * 4608 + t * 72 + 32 * ks + 8 * quad);
    LAS bf16_t* Swr = Sw + wave * 1152 + l15 * 72;
#pragma unroll
    for (int st = 0; st < 4; ++st) { f32x4 acc = {0.f, 0.f, 0.f, 0.f};
#pragma unroll
        for (int ks = 0; ks < 2; ++ks) acc = MFMA16(LDSFRAG(KTl + dir * 4608 + (16 * st + l15) * 72 + 32 * ks + 8 * quad), qf[ks], acc);
        float val[4];
#pragma unroll
        for (int j = 0; j < 4; ++j) { const int s = 16 * st + 4 * quad + j; const bool ok = dir ? (s >= t) : (s <= t); val[j] = ok ? acc[j] : 0.f; }
        u32x2 o; o.x = cvt_pk_bf16(val[0], val[1]); o.y = cvt_pk_bf16(val[2], val[3]); *(LAS u32x2*)(Swr + 16 * st + 4 * quad) = o; }
    asm volatile("s_waitcnt lgkmcnt(0)" ::: "memory");
    f32x4 a1[6];
#pragma unroll
    for (int et = 0; et < 6; ++et) a1[et] = (f32x4){0.f, 0.f, 0.f, 0.f};
#pragma unroll
    for (int ks = 0; ks < 2; ++ks) { const bf16x8 sf = LDSFRAG(Swr + 32 * ks + 8 * quad);
#pragma unroll
        for (int et = 0; et < 6; ++et) { a1[et] = MFMA16(LDSFRAG(VT + (16 * et + l15) * 72 + 32 * ks + 8 * quad), sf, a1[et]);
            a1[et] = MFMA16(LDSFRAG(STs + dir * 6912 + (16 * et + l15) * 72 + 32 * ks + 8 * quad), qf[ks], a1[et]); } }
    __syncthreads();
    if (dir == 1) {
#pragma unroll
        for (int et = 0; et < 6; ++et) *(LAS f32x4*)(HB + t * 100 + 16 * et + 4 * quad) = a1[et];
    }
    __syncthreads();
    if (dir == 0) { float ss = 0.f;
#pragma unroll
        for (int et = 0; et < 6; ++et) { a1[et] = a1[et] + *(const LAS f32x4*)(HB + t * 100 + 16 * et + 4 * quad); ss += (a1[et][0] * a1[et][0] + a1[et][1] * a1[et][1]) + (a1[et][2] * a1[et][2] + a1[et][3] * a1[et][3]); }
        ss += __shfl_xor(ss, 16); ss += __shfl_xor(ss, 32);
        const float r = rsqrtf(ss * (1.f / 96.f) + RMS_EPS);
        const size_t row = (size_t)(ug.rowbase + t);
#pragma unroll
        for (int et = 0; et < 6; ++et) { const int e = 16 * et + 4 * quad; const f32x4 g4 = *(const f32x4*)(ng + e);
            float gc[4]; unpack4(*(const uint2*)(PROJ + row * NINP + 2832 + h * 96 + e), gc);
            u32x2 o; o.x = cvt_pk_bf16(a1[et][0] * r * g4[0] * silu_(gc[0]), a1[et][1] * r * g4[1] * silu_(gc[1])); o.y = cvt_pk_bf16(a1[et][2] * r * g4[2] * silu_(gc[2]), a1[et][3] * r * g4[3] * silu_(gc[3]));
            *(u32x2*)(Y + row * D + 640 + h * 96 + e) = o; } }
}

__device__ __forceinline__ void sgu_unit(const Params& P, LAS unsigned char* lds, int l, int su, int tid, int wave, int lane) {
    const bf16_t* PROJ = (const bf16_t*)(P.ws + WS_PROJ); bf16_t* Y = (bf16_t*)(P.ws + WS_HY);
    LAS bf16_t* VT2 = (LAS bf16_t*)lds;
    const int rowbase = (su < 512) ? (su >> 6) * 8192 + (su & 63) * 128 : MLAT + ((su - 512) >> 1) * 256 + ((su - 512) & 1) * 128;
    const float* ng = P.in[15] + l * 256; const float* sw = P.in[16] + (size_t)l * 4 * 128 * 128; const float* sb = P.in[17] + l * 4 * 128;
    __syncthreads();
    { const int s = tid >> 2, qtr = tid & 3; float ss = 0.f; float gv[64];
#pragma unroll
        for (int i = 0; i < 8; ++i) { float x[8]; unpack8(*(const uint4*)(PROJ + (size_t)(rowbase + s) * NINP + 1808 + qtr * 64 + i * 8), x);
#pragma unroll
            for (int j = 0; j < 8; ++j) { const float gl = gelu_(x[j]); gv[i * 8 + j] = gl; ss += gl * gl; } }
        ss += __shfl_xor(ss, 1); ss += __shfl_xor(ss, 2);
        const float rstd = rsqrtf(ss * (1.f / 256.f) + RMS_EPS);
#pragma unroll
        for (int i = 0; i < 64; ++i) VT2[(qtr * 64 + i) * 136 + s] = f2bf1(gv[i] * rstd * ng[qtr * 64 + i]); }
    __syncthreads();
    const int l15 = lane & 15, quad = lane >> 4, t = 16 * wave + l15; const size_t row = (size_t)(rowbase + t);
#pragma unroll 1
    for (int g = 0; g < 4; ++g) { f32x4 acc[4];
#pragma unroll
        for (int ct = 0; ct < 4; ++ct) acc[ct] = (f32x4){0.f, 0.f, 0.f, 0.f};
#pragma unroll
        for (int ks = 0; ks < 4; ++ks) { const float* wp = sw + ((size_t)g * 128 + t) * 128 + 32 * ks + 8 * quad; const f32x4 wa = *(const f32x4*)wp, wb = *(const f32x4*)(wp + 4);
            union { u32x4 u; bf16x8 b; } wf; wf.u.x = cvt_pk_bf16(wa[0], wa[1]); wf.u.y = cvt_pk_bf16(wa[2], wa[3]); wf.u.z = cvt_pk_bf16(wb[0], wb[1]); wf.u.w = cvt_pk_bf16(wb[2], wb[3]);
#pragma unroll
            for (int ct = 0; ct < 4; ++ct) acc[ct] = MFMA16(LDSFRAG(VT2 + (g * 64 + 16 * ct + l15) * 136 + 32 * ks + 8 * quad), wf.b, acc[ct]); }
        const float bias = sb[g * 128 + t];
#pragma unroll
        for (int ct = 0; ct < 4; ++ct) { const int c = g * 64 + 16 * ct + 4 * quad; float ub[4]; unpack4(*(const uint2*)(PROJ + row * NINP + 1552 + c), ub);
            u32x2 o; o.x = cvt_pk_bf16(gelu_(ub[0]) * (acc[ct][0] + bias), gelu_(ub[1]) * (acc[ct][1] + bias)); o.y = cvt_pk_bf16(gelu_(ub[2]) * (acc[ct][2] + bias), gelu_(ub[3]) * (acc[ct][3] + bias));
            *(u32x2*)(Y + row * D + 384 + c) = o; } }
}

__device__ __forceinline__ void phase_scan(const Params& P, int tid) {
    bf16_t* STA = (bf16_t*)(P.ws + WS_STA); bf16_t* STC = (bf16_t*)(P.ws + WS_STC);
    const float* DECA = (const float*)(P.ws + WS_DECA); const float* DECC = (const float*)(P.ws + WS_DECC);
    const int gt = blockIdx.x * 512 + tid, NT = gridDim.x * 512;
    constexpr int NA = 64 * 1164, NC = 64 * 576;
    for (int item = gt; item < NA + NC; item += NT) {
        if (item < NA) {
            const int sidx = item / 1164, v = item % 1164, dir = sidx & 1;
            bf16_t* base = STA + (size_t)sidx * NCH * SA_SZ + v * 8; const float* dec = DECA + sidx * NCH;
            float st[8];
#pragma unroll
            for (int e = 0; e < 8; ++e) st[e] = 0.f;
#pragma unroll 1
            for (int j0 = 0; j0 < NCH; j0 += 12) { uint4 u[12]; float dc[12];
#pragma unroll
                for (int q = 0; q < 12; ++q) { const int j = j0 + q, ci = dir ? (j < 4 ? 3 - j : 135 - j) : j; u[q] = *(const uint4*)(base + (size_t)ci * SA_SZ); dc[q] = dec[ci]; }
#pragma unroll
                for (int q = 0; q < 12; ++q) { const int j = j0 + q, ci = dir ? (j < 4 ? 3 - j : 135 - j) : j; float f[8]; unpack8(u[q], f);
                    *(uint4*)(base + (size_t)ci * SA_SZ) = pack8(st);
#pragma unroll
                    for (int e = 0; e < 8; ++e) st[e] = dc[q] * st[e] + f[e]; } }
        } else {
            const int it2 = item - NA, sidx = it2 / 576, v = it2 % 576, dir = sidx & 1, d0 = (v % 6) * 8;
            bf16_t* base = STC + (size_t)sidx * NCH * SC_SZ + v * 8; const float* dec = DECC + (size_t)sidx * NCH * 48 + d0;
            float st[8];
#pragma unroll
            for (int e = 0; e < 8; ++e) st[e] = 0.f;
#pragma unroll 1
            for (int j0 = 0; j0 < NCH; j0 += 6) { uint4 u[6]; f32x4 da[6], db[6];
#pragma unroll
                for (int q = 0; q < 6; ++q) { const int j = j0 + q, ci = dir ? (j < 4 ? 3 - j : 135 - j) : j; u[q] = *(const uint4*)(base + (size_t)ci * SC_SZ); da[q] = *(const f32x4*)(dec + ci * 48); db[q] = *(const f32x4*)(dec + ci * 48 + 4); }
#pragma unroll
                for (int q = 0; q < 6; ++q) { const int j = j0 + q, ci = dir ? (j < 4 ? 3 - j : 135 - j) : j; float f[8]; unpack8(u[q], f);
                    *(uint4*)(base + (size_t)ci * SC_SZ) = pack8(st);
#pragma unroll
                    for (int e = 0; e < 8; ++e) st[e] = (e < 4 ? da[q][e & 3] : db[q][e & 3]) * st[e] + f[e]; } }
        }
    }
}
#ifndef PH_STOP
#define PH_STOP 37
#endif
#ifndef DBG_SKIP
#define DBG_SKIP 0
#endif
#ifndef PHSEL
#define PHSEL 0xFFFF
#endif


#ifdef DBG_SCAN
__device__ __forceinline__ bool badf(float v) { return !(fabsf(v) < 1e6f); }
__device__ __forceinline__ void dbg_scan(const Params& P, int tid) {
    unsigned* flag = (unsigned*)(P.ws + 900000);
    const size_t gt = (size_t)blockIdx.x * 512 + tid, NT = (size_t)gridDim.x * 512;
    unsigned f = 0;
    const bf16_t* STA = (const bf16_t*)(P.ws + WS_STA);
    for (size_t i = gt; i < (size_t)64 * NCH * SA_SZ; i += NT) { const float v = __uint_as_float((unsigned)STA[i] << 16);
        if (badf(v)) { if (v != v) f |= 1u; else if (fabsf(v) > 1e38f) f |= 2u; else f |= 4u;
            const int within = (int)(i % SA_SZ), slot = (int)(i / SA_SZ), ci = slot % NCH, sidx = slot / NCH;
            if (within >= 96 * 96) f |= 8u; if (ci < 4) f |= 32u; if (sidx & 1) f |= 64u; } }
    const bf16_t* STC = (const bf16_t*)(P.ws + WS_STC);
    for (size_t i = gt; i < (size_t)64 * NCH * SC_SZ; i += NT) { const float v = __uint_as_float((unsigned)STC[i] << 16); if (badf(v)) f |= 16u; }
    if (f) atomicOr(flag, f);
}
#endif
__global__ void __launch_bounds__(512, 2) hybrid_fwd(Params P) {
    extern __shared__ __attribute__((aligned(16))) unsigned char lds_raw[];
    LAS unsigned char* lds = (LAS unsigned char*)lds_raw;
    cg::grid_group grid = cg::this_grid();
    const int G = gridDim.x;
    float* MOD = (float*)(P.ws + WS_MOD); float* XCTX = (float*)(P.ws + WS_XCTX); float* GATES = (float*)(P.ws + WS_GATES);
    bf16_t* HY = (bf16_t*)(P.ws + WS_HY); bf16_t* PROJ = (bf16_t*)(P.ws + WS_PROJ);
#pragma unroll 1
    for (int ph0 = P.ph_lo; ph0 < P.ph_hi; ++ph0) {
        const int ph = (ph0 >= PH_STOP && ph0 < 37) ? 99 : ph0;
        int tid = threadIdx.x; asm volatile("" : "+v"(tid));
        const int lane = tid & 63, wave = __builtin_amdgcn_readfirstlane(tid >> 6);
#ifdef DBG_SCAN
        if (ph0 == 0 && blockIdx.x == 0 && tid == 0) *(unsigned*)(P.ws + 900000) = 0u;
#ifndef DBG_P1
        if (ph0 == 36) dbg_scan(P, tid);
#endif
        if (ph0 == 37) { const unsigned fl = *(volatile unsigned*)(P.ws + 900000); for (size_t i = (size_t)blockIdx.x * 512 + tid; i < (size_t)MLAT * D; i += (size_t)gridDim.x * 512) P.out[i] = 1000.f * (float)fl; }
        else
#endif
        if (ph == 99) {} else if (ph == 0) { if (PHSEL & 1) phase_prologue(P, lds, tid, wave, lane); }
        else if (ph == 37) { if (PHSEL & 2) phase_final(P.out, P.in[21], wave, lane); }
        else {
            const int l = (ph - 1) / 9, s = (ph - 1) % 9; const int Mrows = (l == 3) ? MLAT : MTOT; const float* modl = MOD + (size_t)l * 9 * 6144;
            if (s == 0) { if (PHSEL & (4 << 0)) {
                if (l == 0) phase_norm(P.in[0], P.in[2], P.out, XCTX, P.in[4], modl, 0, 1, HY, MTOT, wave, lane);
                else phase_norm(P.out, XCTX, nullptr, nullptr, P.in[4] + l * D, modl, 0, 1, HY, MTOT, wave, lane);
            } } else if (s == 1) { if (PHSEL & (4 << 1)) {
                pg8::Gemm g{HY, (const bf16_t*)(P.ws + WS_WIN) + (size_t)l * NINP * 1024, MTOT, NINP, 1024}; pg8::StaticOrder S; S.init(MTOT, NINP, G, (int)blockIdx.x);
                EpiProj E{PROJ, GATES, l & 1};
                pg8::gemm_phase<EpiProj, pg8::StaticOrder, false>(lds, g, S, E, nullptr, tid);
            } } else if (s == 2) { if (PHSEL & (4 << 2)) {
                const int nun = 8448 + ((l == 3) ? 512 : 528);
#pragma unroll 1
                for (int u = blockIdx.x; u < nun; u += G) {
                    if (u < 4224) { const int ci = u % NCH, bh = u / NCH; mlstm_p1_unit(P, lds, l, bh >> 2, bh & 3, ci, tid, wave, lane); }
                    else if (u < 8448) { const int v = u - 4224, ci = v % NCH, bh = v / NCH; gla_p1_unit(P, lds, l, bh >> 2, bh & 3, ci, tid, wave, lane); }
                    else sgu_unit(P, lds, l, u - 8448, tid, wave, lane);
                }
            } } else if (s == 3) { if (PHSEL & (4 << 3)) {
                phase_scan(P, tid);
            } } else if (s == 4) { if (PHSEL & (4 << 4)) {
#pragma unroll 1
                for (int u = blockIdx.x; u < 8448; u += G) {
                    const int v = (u < 4224) ? u : u - 4224, ci = v % NCH, bh = v / NCH;
                    if (l == 3 && ci < 4) continue;
                    if (u < 4224) { if (!(DBG_SKIP & 1)) mlstm_p3_unit(P, lds, l, bh >> 2, bh & 3, ci, tid, wave, lane); }
                    else { if (!(DBG_SKIP & 2)) gla_p3_unit(P, lds, l, bh >> 2, bh & 3, ci, tid, wave, lane); }
                }
            } } else if (s == 5) { if (PHSEL & (4 << 5)) {
                pg8::Gemm g{HY, (const bf16_t*)(P.ws + WS_WOUT) + (size_t)l * 1024 * 1024, Mrows, 1024, 1024}; pg8::StaticOrder S; S.init(Mrows, 1024, G, (int)blockIdx.x);
                EpiRes E{P.out, XCTX, modl + 2 * 1024, l & 1};
                pg8::gemm_phase<EpiRes, pg8::StaticOrder, false>(lds, g, S, E, nullptr, tid);
            } } else if (s == 6) { if (PHSEL & (4 << 6)) {
                phase_norm(P.out, XCTX, nullptr, nullptr, P.in[5] + l * D, modl, 3, 4, HY, Mrows, wave, lane);
            } } else if (s == 7) { if (PHSEL & (4 << 7)) {
                pg8::Gemm g{HY, (const bf16_t*)(P.ws + WS_WFI) + (size_t)l * 5632 * 1024, Mrows, 5632, 1024}; pg8::StaticOrder S; S.init(Mrows, 5632, G, (int)blockIdx.x);
                EpiFfn E{PROJ};
                pg8::gemm_phase<EpiFfn, pg8::StaticOrder, false>(lds, g, S, E, nullptr, tid);
            } } else { if (PHSEL & (4 << 8)) {
                pg8::Gemm g{PROJ, (const bf16_t*)(P.ws + WS_WFO) + (size_t)l * 1024 * DFF, Mrows, 1024, DFF}; pg8::StaticOrder S; S.init(Mrows, 1024, G, (int)blockIdx.x);
                EpiRes E{P.out, XCTX, modl + 5 * 1024, 0};
                pg8::gemm_phase<EpiRes, pg8::StaticOrder, false>(lds, g, S, E, nullptr, tid);
            } }
        }
        if (ph0 + 1 < P.ph_hi) {
            __builtin_amdgcn_fence(__ATOMIC_RELEASE, "agent"); asm volatile("s_waitcnt vmcnt(0)" ::: "memory");
            grid.sync();
            __builtin_amdgcn_fence(__ATOMIC_ACQUIRE, "agent"); asm volatile("s_waitcnt vmcnt(0)" ::: "memory"); }
    }
}

extern "C" void kernel_launch(void* const* d_in, const int* in_sizes, int n_in, void* d_out, int out_size, void* d_ws, size_t ws_size, hipStream_t stream) {
    static int grid = 0;
    if (grid == 0) {
        if (n_in != 22 || out_size != MLAT * D || ws_size < WS_END) { fprintf(stderr, "kernel_launch: unexpected shapes (n_in %d out %d ws %zu)\n", n_in, out_size, ws_size); grid = -1; return; }
        int dev = 0, cus = 0, per_cu = 0;
        hipGetDevice(&dev); hipDeviceGetAttribute(&cus, hipDeviceAttributeMultiprocessorCount, dev);
        if (hipFuncSetAttribute((const void*)hybrid_fwd, hipFuncAttributeMaxDynamicSharedMemorySize, LDS_BYTES) != hipSuccess) { fprintf(stderr, "kernel_launch: hipFuncSetAttribute failed\n"); grid = -1; return; }
        if (hipOccupancyMaxActiveBlocksPerMultiprocessor(&per_cu, (const void*)hybrid_fwd, 512, LDS_BYTES) != hipSuccess || per_cu < 1) { fprintf(stderr, "kernel_launch: occupancy query says %d\n", per_cu); per_cu = 1; }
        (void)hipGetLastError();
        grid = cus * per_cu;
    }
    if (grid < 0) return;
    Params p{};
    for (int i = 0; i < 22; ++i) p.in[i] = (const float*)d_in[i];
    p.out = (float*)d_out; p.ws = (unsigned char*)d_ws; p.ph_lo = 0; p.ph_hi = 38;
    void* args[] = {&p};
    hipError_t e = hipLaunchCooperativeKernel((const void*)hybrid_fwd, dim3(grid), dim3(512), args, LDS_BYTES, stream);
    if (e != hipSuccess) fprintf(stderr, "cooperative launch failed: %s (grid %d)\n", hipGetErrorString(e), grid);
}
```

```cpp
#include <hip/hip_runtime.h>
#include <hip/hip_cooperative_groups.h>
#include <cstdio>
namespace cg = cooperative_groups;
namespace pg8 {
#define PG8_LAS __attribute__((address_space(3)))
typedef unsigned short bf16_t;
typedef short bf16x8 __attribute__((ext_vector_type(8)));
typedef float f32x4 __attribute__((ext_vector_type(4)));
typedef unsigned u32x4 __attribute__((ext_vector_type(4)));
constexpr int BM = 256, BK = 64, HALF = 128, HTB = HALF * BK * 2  , STAGE_BYTES = 8 * HTB, NXCD = 8, WGM = 4;

__host__ __device__ __forceinline__ int lds_byte(int r, int c) { const int st = (r >> 4) * 2 + (c >> 5), rr = r & 15, cc = c & 31, ob = rr * 64 + cc * 2; return st * 1024 + (ob ^ (((ob >> 9) & 1) << 5)); }
__host__ __device__ __forceinline__ void stage_rc(int b, int& R, int& C) { const int st = b / 1024, sb = b % 1024, swz = sb ^ (((sb >> 9) & 1) << 5); R = (st >> 1) * 16 + swz / 64; C = (st & 1) * 32 + (swz % 64) / 2; }
__host__ __device__ __forceinline__ int perm32(int rho) { const int n = rho >> 4, i = rho & 15; return 8 * (i >> 2) + 4 * n + (i & 3); }

struct Unit { int pm, pn; };
struct Gemm { const bf16_t* A; const bf16_t* Bt; int M, N, K; };

struct StaticOrder {
    int nM, nN, nwg, G, c;
    __host__ __device__ void init(int M, int N, int G_, int c_) { nM = M / BM; nN = N / BM; nwg = nM * nN; G = G_; c = c_; }
    __host__ __device__ bool next(int i, Unit& u) const {
        const long L = (long)i * G + c; if (L >= nwg) return false;
        int wgid = (int)L; { const int q = nwg / NXCD, r = nwg % NXCD, xcd = wgid % NXCD, off = wgid / NXCD; wgid = (xcd < r ? xcd * (q + 1) : r * (q + 1) + (xcd - r) * q) + off; }
        const int nig = WGM * nN, gid = wgid / nig, fm = gid * WGM, gsz = (nM - fm) < WGM ? (nM - fm) : WGM;
        u.pm = fm + ((wgid % nig) % gsz); u.pn = (wgid % nig) / gsz; return true;
    }
    __device__ __forceinline__ void a_ready(const Unit&) const {}
    __device__ __forceinline__ void done(const Unit&) const {}
};
typedef float f32x2 __attribute__((ext_vector_type(2)));
typedef __bf16 bf16x2_n __attribute__((ext_vector_type(2)));
__device__ __forceinline__ unsigned cvt_pk_bf16(float lo, float hi) { f32x2 v = {lo, hi}; return __builtin_bit_cast(unsigned, __builtin_convertvector(v, bf16x2_n)); }
typedef float f32x2 __attribute__((ext_vector_type(2)));
template <class Epi, class Sched, bool STAMP = false>
__device__ __forceinline__ void gemm_phase(PG8_LAS unsigned char* lds, const Gemm g, const Sched& S, const Epi& E, unsigned long long* stamps, const int tid) {
    const int wid = __builtin_amdgcn_readfirstlane(tid >> 6), lane = tid & 63, wr = wid >> 2, wc = wid & 3, fr = lane & 15, fq = lane >> 4;
    const int K = g.K, nt = K / BK;
    int ts_lo = 0, ts_hi = 0, nts = 0; const unsigned long long rt_entry = STAMP ? (unsigned long long)wall_clock64() : 0ull;
#define PG8_STAMP() do { if (STAMP && wid == 0 && nts < 64) { const unsigned long long _c = (unsigned long long)clock64(); \
        ts_lo = (lane == nts) ? (int)(unsigned)_c : ts_lo; ts_hi = (lane == nts) ? (int)(unsigned)(_c >> 32) : ts_hi; ++nts; } } while (0)
    PG8_STAMP();
    unsigned voffA[2], voffB[2];
#pragma unroll
    for (int i = 0; i < 2; ++i) { int R, C; stage_rc(tid * 16 + i * 8192, R, C); const int Rb = Epi::PERM ? ((R & ~31) + perm32(R & 31)) : R;
        voffA[i] = (unsigned)(R * K + C) * 2u; voffB[i] = (unsigned)(Rb * K + C) * 2u; }
    const size_t kstep = (size_t)(BK * 2);
    const size_t hstep = (size_t)HALF * K * 2;
    const size_t tstep = 2 * hstep;
    const unsigned ldsw = (unsigned)wid * 1024u;
    const int aoff = lds_byte(wr * 64 + fr, fq * 8), boff = lds_byte(wc * 32 + fr, fq * 8);
#define PG8_SA(b, h) (((b) * 2 + (h)) * HTB)
#define PG8_SB(b, h) ((4 + (b) * 2 + (h)) * HTB)
#define PG8_STAGE(bufoff, gbase, voff) do { _Pragma("unroll") for (int _i = 0; _i < 2; ++_i) \
        __builtin_amdgcn_global_load_lds((const unsigned*)((const char*)(gbase) + (voff)[_i]), (PG8_LAS unsigned*)(lds + (bufoff) + ldsw + _i * 8192), 16, 0, 0); } while (0)
#define PG8_LDA(dst, b, h) do { _Pragma("unroll") for (int m = 0; m < 4; ++m) _Pragma("unroll") for (int k = 0; k < 2; ++k) dst[m][k] = *(const PG8_LAS bf16x8*)(lds + PG8_SA(b, h) + aoff + m * 2048 + k * 1024); } while (0)
#define PG8_LDB(dst, b, h) do { _Pragma("unroll") for (int n = 0; n < 2; ++n) _Pragma("unroll") for (int k = 0; k < 2; ++k) dst[n][k] = *(const PG8_LAS bf16x8*)(lds + PG8_SB(b, h) + boff + n * 2048 + k * 1024); } while (0)
#define PG8_MMA(ai, bj, At, Bt) do { __builtin_amdgcn_s_setprio(1); _Pragma("unroll") for (int m = 0; m < 4; ++m) _Pragma("unroll") for (int n = 0; n < 2; ++n) _Pragma("unroll") for (int k = 0; k < 2; ++k) \
        acc[ai][bj][m][n] = __builtin_amdgcn_mfma_f32_16x16x32_bf16(Bt[n][k], At[m][k], acc[ai][bj][m][n], 0, 0, 0); __builtin_amdgcn_s_setprio(0); } while (0)
#define PG8_WAIT_V(n) asm volatile("s_waitcnt vmcnt(" #n ")" ::: "memory")
#define PG8_WAIT_L(n) asm volatile("s_waitcnt lgkmcnt(" #n ")" ::: "memory")
#define PG8_BAR __builtin_amdgcn_s_barrier()
#define PG8_SCHED __builtin_amdgcn_sched_barrier(0)
    Unit cur, nxt; int ui = 0;
    if (!S.next(0, cur)) return;
    f32x4 acc[2][2][4][2];
#pragma unroll
    for (int a = 0; a < 2; ++a)
#pragma unroll
        for (int b = 0; b < 2; ++b)
#pragma unroll
            for (int m = 0; m < 4; ++m)
#pragma unroll
                for (int n = 0; n < 2; ++n) acc[a][b][m][n] = (f32x4){0.f, 0.f, 0.f, 0.f};
    bf16x8 At[4][2], B0[2][2], B1[2][2];
    const char* cA = (const char*)g.A + (size_t)cur.pm * tstep; const char* cB = (const char*)g.Bt + (size_t)cur.pn * tstep;
    S.a_ready(cur);
    PG8_STAGE(PG8_SB(0, 0), cB, voffB); PG8_STAGE(PG8_SA(0, 0), cA, voffA); PG8_STAGE(PG8_SB(0, 1), cB + hstep, voffB); PG8_STAGE(PG8_SA(0, 1), cA + hstep, voffA);
    if (wr == 1) PG8_BAR;
    PG8_WAIT_V(4); PG8_BAR;
    PG8_STAGE(PG8_SB(1, 0), cB + kstep, voffB); PG8_STAGE(PG8_SA(1, 0), cA + kstep, voffA); PG8_STAGE(PG8_SB(1, 1), cB + hstep + kstep, voffB);
    PG8_WAIT_V(6); PG8_BAR;
    PG8_STAMP();
    for (;;) {
        const bool has_next = S.next(ui + 1, nxt);
        const char* nA = has_next ? (const char*)g.A + (size_t)nxt.pm * tstep : cA; const char* nB = has_next ? (const char*)g.Bt + (size_t)nxt.pn * tstep : cB;
        for (int t = 0; t < nt; t += 2) {
            const bool last = (t == nt - 2);
            const char* a1 = cA + (size_t)(t + 1) * kstep;
            const char* a2 = last ? nA : cA + (size_t)(t + 2) * kstep; const char* b2 = last ? nB : cB + (size_t)(t + 2) * kstep;
            const char* a3 = a2 + kstep; const char* b3 = b2 + kstep;
            if (last && has_next) S.a_ready(nxt);
            PG8_LDB(B0, 0, 0); PG8_SCHED; PG8_LDA(At, 0, 0); PG8_STAGE(PG8_SA(1, 1), a1 + hstep, voffA);
            PG8_WAIT_L(8); PG8_BAR; PG8_WAIT_L(0); PG8_MMA(0, 0, At, B0); PG8_BAR; PG8_SCHED;
            PG8_LDB(B1, 0, 1); PG8_STAGE(PG8_SB(0, 0), b2, voffB);
            PG8_BAR; PG8_WAIT_L(0); PG8_MMA(0, 1, At, B1); PG8_BAR;
            PG8_LDA(At, 0, 1); PG8_STAGE(PG8_SA(0, 0), a2, voffA);
            PG8_BAR; PG8_WAIT_L(0); PG8_MMA(1, 0, At, B0); PG8_BAR; PG8_SCHED;
            PG8_STAGE(PG8_SB(0, 1), b2 + hstep, voffB);
            PG8_WAIT_V(6); PG8_BAR; PG8_MMA(1, 1, At, B1); PG8_BAR;
            PG8_LDB(B0, 1, 0); PG8_SCHED; PG8_LDA(At, 1, 0); PG8_STAGE(PG8_SA(0, 1), a2 + hstep, voffA);
            PG8_WAIT_L(8); PG8_BAR; PG8_WAIT_L(0); PG8_MMA(0, 0, At, B0); PG8_BAR; PG8_SCHED;
            PG8_LDB(B1, 1, 1); PG8_STAGE(PG8_SB(1, 0), b3, voffB);
            PG8_BAR; PG8_WAIT_L(0); PG8_MMA(0, 1, At, B1); PG8_BAR;
            PG8_LDA(At, 1, 1); PG8_STAGE(PG8_SA(1, 0), a3, voffA);
            PG8_BAR; PG8_WAIT_L(0); PG8_MMA(1, 0, At, B0); PG8_BAR; PG8_SCHED;
            PG8_STAGE(PG8_SB(1, 1), b3 + hstep, voffB);
            PG8_WAIT_V(6); PG8_BAR; PG8_MMA(1, 1, At, B1); PG8_BAR;
        }
        PG8_STAMP();
        if constexpr (!Epi::AFTER_DRAIN) { E(acc, cur, wr, wc, fr, fq); S.done(cur); }
        PG8_STAMP();
        if (!has_next) break;
#pragma unroll
        for (int a = 0; a < 2; ++a)
#pragma unroll
            for (int b = 0; b < 2; ++b)
#pragma unroll
                for (int m = 0; m < 4; ++m)
#pragma unroll
                    for (int n = 0; n < 2; ++n) acc[a][b][m][n] = (f32x4){0.f, 0.f, 0.f, 0.f};
        cur = nxt; cA = nA; cB = nB; ++ui;
    }
    PG8_WAIT_V(0);
    if (wr == 0) PG8_BAR;
    PG8_BAR;
    if constexpr (Epi::AFTER_DRAIN) { E.fused(acc, cur, wr, wc, fr, fq, lds, wid, lane); S.done(cur); }
    PG8_STAMP();
    if (STAMP && wid == 0) { stamps[lane] = lane < nts ? (((unsigned long long)(unsigned)ts_hi << 32) | (unsigned)ts_lo) : 0ull;
        if (lane == 62) stamps[62] = rt_entry; if (lane == 63) stamps[63] = (unsigned long long)wall_clock64(); }
#undef PG8_STAMP
#undef PG8_SA
#undef PG8_SB
#undef PG8_STAGE
#undef PG8_LDA
#undef PG8_LDB
#undef PG8_MMA
#undef PG8_WAIT_V
#undef PG8_WAIT_L
#undef PG8_BAR
#undef PG8_SCHED
}
}

using pg8::bf16_t; using pg8::bf16x8; using pg8::f32x4; using pg8::u32x4; using pg8::cvt_pk_bf16;
#define LAS __attribute__((address_space(3)))
typedef unsigned u32x2 __attribute__((ext_vector_type(2)));

constexpr int D = 1024, MLAT = 65536, MCTX = 2048, MTOT = 67584, NIN = 3248, NINP = 3328, DFF = 2816;
constexpr int NCH = 132;
constexpr int SA_SZ = 97 * 96, SC_SZ = 96 * 48;
constexpr int LDS_BYTES = 147712, XB_LDS_OFF = 147456;
constexpr float RMS_EPS = 1e-6f;

constexpr size_t MiB = 1u << 20;
constexpr size_t WS_BAR = 3932160;
constexpr size_t WS_MOD = 0, WS_DECA = 1 * MiB, WS_DECC = 2 * MiB, WS_WIN = 4 * MiB, WS_WOUT = 30 * MiB, WS_WFI = 38 * MiB, WS_WFO = 82 * MiB,
                 WS_XCTX = 104 * MiB, WS_GATES = 112 * MiB, WS_HY = 125 * MiB, WS_PROJ = 257 * MiB, WS_STA = 686 * MiB, WS_STC = 837 * MiB, WS_LAG = 912 * MiB, WS_SHW2 = 1011 * MiB, WS_PARTA = 1012 * MiB, WS_PARTB = 1017 * MiB, WS_END = 1022 * MiB;
constexpr size_t WS_GM = 1114112, WS_SHW1 = 1441792;

struct Params { const float* in[22]; float* out; unsigned char* ws; int ph_lo, ph_hi; };
typedef const __attribute__((address_space(4))) Params CParams;

__device__ __forceinline__ float bflo(unsigned u) { return __uint_as_float(u << 16); }
__device__ __forceinline__ float bfhi(unsigned u) { return __uint_as_float(u & 0xffff0000u); }
__device__ __forceinline__ void unpack8(const uint4 v, float (&f)[8]) { f[0] = bflo(v.x); f[1] = bfhi(v.x); f[2] = bflo(v.y); f[3] = bfhi(v.y); f[4] = bflo(v.z); f[5] = bfhi(v.z); f[6] = bflo(v.w); f[7] = bfhi(v.w); }
__device__ __forceinline__ void unpack4(const uint2 v, float (&f)[4]) { f[0] = bflo(v.x); f[1] = bfhi(v.x); f[2] = bflo(v.y); f[3] = bfhi(v.y); }
__device__ __forceinline__ uint4 pack8(const float (&f)[8]) { uint4 r; r.x = cvt_pk_bf16(f[0], f[1]); r.y = cvt_pk_bf16(f[2], f[3]); r.z = cvt_pk_bf16(f[4], f[5]); r.w = cvt_pk_bf16(f[6], f[7]); return r; }
__device__ __forceinline__ bf16_t f2bf1(float f) { return (bf16_t)(cvt_pk_bf16(f, 0.f) & 0xffffu); }
__device__ __forceinline__ float fexp_(float x) { return __builtin_amdgcn_exp2f(x * 1.4426950408889634f); }
__device__ __forceinline__ float sigmoid_(float x) { return __builtin_amdgcn_rcpf(1.f + __builtin_amdgcn_exp2f(x * -1.4426950408889634f)); }
__device__ __forceinline__ float silu_(float x) { return x * sigmoid_(x); }
__device__ __forceinline__ float logsigmoid_(float x) { return fminf(x, 0.f) - 0.6931471805599453f * __builtin_amdgcn_logf(1.f + fexp_(-fabsf(x))); }
__device__ __forceinline__ float gelu_(float x) { const float u = 0.7978845608f * (x + 0.044715f * x * x * x); const float t = 1.f - 2.f * __builtin_amdgcn_rcpf(1.f + __builtin_amdgcn_exp2f(u * 2.8853900817779268f)); return 0.5f * x * (1.f + t); }
template <int CTRL, int ROWMASK> __device__ __forceinline__ float dpp_shift(float v) {
    return __builtin_bit_cast(float, __builtin_amdgcn_update_dpp(0, __builtin_bit_cast(int, v), CTRL, ROWMASK, 0xf, true));
}
__device__ __forceinline__ float wave_incl_scan(float v, int  ) {
    v += dpp_shift<0x111, 0xf>(v); v += dpp_shift<0x112, 0xf>(v); v += dpp_shift<0x114, 0xf>(v); v += dpp_shift<0x118, 0xf>(v);
    v += dpp_shift<0x142, 0xa>(v);
    v += dpp_shift<0x143, 0xc>(v);
    return v;
}
__device__ __forceinline__ float lane63(float v) { return __builtin_bit_cast(float, __builtin_amdgcn_readlane(__builtin_bit_cast(int, v), 63)); }
__device__ __forceinline__ float wave_sum(float v) { return lane63(wave_incl_scan(v, 0)); }
#define MFMA16(a, b, c) __builtin_amdgcn_mfma_f32_16x16x32_bf16((a), (b), (c), 0, 0, 0)
#define LDSFRAG(ptr) (*(const LAS bf16x8*)(ptr))

__device__ __forceinline__ void transpose_item(const float* W, int K, int N, bf16_t* WT, int row0, LAS float* scr, int k0, int n0, int lane) {
    { float wv[32]; const int n = n0 + (lane & 31);
#pragma unroll
      for (int i = 0; i < 32; ++i) wv[i] = (n < N) ? W[(size_t)(k0 + 2 * i + (lane >> 5)) * N + n] : 0.f;
#pragma unroll
      for (int i = 0; i < 32; ++i) scr[(2 * i + (lane >> 5)) * 33 + (lane & 31)] = wv[i]; }
    asm volatile("s_waitcnt lgkmcnt(0)" ::: "memory");
    const int c = lane & 7;
#pragma unroll
    for (int j = 0; j < 4; ++j) { const int n = (lane >> 3) + 8 * j; const LAS float* s = scr + (8 * c) * 33 + n;
        u32x4 o; o.x = cvt_pk_bf16(s[0 * 33], s[1 * 33]); o.y = cvt_pk_bf16(s[2 * 33], s[3 * 33]); o.z = cvt_pk_bf16(s[4 * 33], s[5 * 33]); o.w = cvt_pk_bf16(s[6 * 33], s[7 * 33]);
        *(u32x4*)(WT + (size_t)(row0 + n) * K + k0 + 8 * c) = o; }
    asm volatile("s_waitcnt lgkmcnt(0)" ::: "memory");
}

__device__ __forceinline__ void phase_prologue(CParams& P, LAS unsigned char* lds, int tid, int wave, int lane) {
    const int G = gridDim.x;
    float* MOD = (float*)(P.ws + WS_MOD);
    if ((int)blockIdx.x < 384) {
        LAS float* sv = (LAS float*)lds; LAS float* red = (LAS float*)(lds + 36864);
        for (int i = tid; i < 9 * 1024; i += 512) { const float c = (i < 8192) ? P.in[1][i] : P.in[3][i - 8192]; sv[i] = silu_(c); }
        __syncthreads();
        for (int item = blockIdx.x; item < 384; item += G) {
            const int l = item / 96, nb = item % 96, n = nb * 64 + lane;
            const float* wa = P.in[6] + (size_t)l * 1024 * 6144 + n;
            float acc[9];
#pragma unroll
            for (int r = 0; r < 9; ++r) acc[r] = 0.f;
#pragma unroll 1
            for (int k0 = wave * 128; k0 < wave * 128 + 128; k0 += 16) { float wv[16];
#pragma unroll
                for (int q = 0; q < 16; ++q) wv[q] = wa[(size_t)(k0 + q) * 6144];
#pragma unroll
                for (int q = 0; q < 16; ++q)
#pragma unroll
                    for (int r = 0; r < 9; ++r) acc[r] += sv[r * 1024 + k0 + q] * wv[q]; }
#pragma unroll
            for (int r = 0; r < 9; ++r) red[(wave * 9 + r) * 64 + lane] = acc[r];
            __syncthreads();
            for (int idx = tid; idx < 576; idx += 512) { const int r = idx >> 6, ln = idx & 63; float s = P.in[7][l * 6144 + nb * 64 + ln];
#pragma unroll
                for (int w = 0; w < 8; ++w) s += red[(w * 9 + r) * 64 + ln];
                MOD[(size_t)(l * 9 + r) * 6144 + nb * 64 + ln] = s; }
            __syncthreads();
        }
    }
    __syncthreads();
    LAS float* scr = (LAS float*)(lds + wave * 8704);
    const int gw = blockIdx.x * 8 + wave, NGW = G * 8;
    for (int it = gw; it < 4 * 6400; it += NGW) {
        const int l = it / 6400; int r = it % 6400;
        if (r < 1664) { const int kb = r / 104, nb = r % 104;
            transpose_item(P.in[8] + (size_t)l * 1024 * NIN, 1024, NIN, (bf16_t*)(P.ws + WS_WIN) + (size_t)l * NINP * 1024, nb * 32, scr, kb * 64, nb * 32, lane); continue; }
        r -= 1664;
        if (r < 512) { const int kb = r / 32, nb = r % 32;
            transpose_item(P.in[18] + (size_t)l * 1024 * 1024, 1024, 1024, (bf16_t*)(P.ws + WS_WOUT) + (size_t)l * 1024 * 1024, nb * 32, scr, kb * 64, nb * 32, lane); continue; }
        r -= 512;
        if (r < 2816) { const int kb = r / 176, nb = r % 176, n0 = nb * 32;
            const int row0 = (n0 < DFF) ? (n0 / 128) * 256 + (n0 % 128) : ((n0 - DFF) / 128) * 256 + 128 + ((n0 - DFF) % 128);
            transpose_item(P.in[19] + (size_t)l * 1024 * 5632, 1024, 5632, (bf16_t*)(P.ws + WS_WFI) + (size_t)l * 5632 * 1024, row0 - n0 + n0  , scr, kb * 64, n0, lane); continue; }
        r -= 2816;
        { const int kb = r / 32, nb = r % 32;
            transpose_item(P.in[20] + (size_t)l * DFF * 1024, DFF, 1024, (bf16_t*)(P.ws + WS_WFO) + (size_t)l * 1024 * DFF, nb * 32, scr, kb * 64, nb * 32, lane); }
    }
}

__device__ __forceinline__ void phase_norm(const float* xl, const float* xc, float* cl, float* cc, const float* g, const float* mod  , int ish, int isc, bf16_t* H, int rbeg, int M, int wave, int lane) {
    const int gw = blockIdx.x * 8 + wave, NGW = gridDim.x * 8, rpw = (M - rbeg + NGW - 1) / NGW;
    const int r0 = rbeg + gw * rpw, r1 = (r0 + rpw < M) ? r0 + rpw : M;
    f32x4 ca[4], cb[4]; int rcur = -1;
    for (int row = r0; row < r1; row += 2) {
        const bool two = (row + 1 < r1);
        const int rowb = two ? row + 1 : row;
        const float* srca = (row < MLAT) ? xl + (size_t)row * D : xc + (size_t)(row - MLAT) * D;
        const float* srcb = (rowb < MLAT) ? xl + (size_t)rowb * D : xc + (size_t)(rowb - MLAT) * D;
        f32x4 va[4], vb[4]; float sa = 0.f, sb = 0.f;
#pragma unroll
        for (int j = 0; j < 4; ++j) { va[j] = *(const f32x4*)(srca + 4 * (lane + 64 * j)); vb[j] = *(const f32x4*)(srcb + 4 * (lane + 64 * j)); }
#pragma unroll
        for (int j = 0; j < 4; ++j) { sa += (va[j][0] * va[j][0] + va[j][1] * va[j][1]) + (va[j][2] * va[j][2] + va[j][3] * va[j][3]); sb += (vb[j][0] * vb[j][0] + vb[j][1] * vb[j][1]) + (vb[j][2] * vb[j][2] + vb[j][3] * vb[j][3]); }
        sa = wave_sum(sa); sb = wave_sum(sb);
        const float rsa = __builtin_amdgcn_rsqf(sa * (1.f / D) + RMS_EPS), rsb = __builtin_amdgcn_rsqf(sb * (1.f / D) + RMS_EPS);
        if (cl) { float* da = (row < MLAT) ? cl + (size_t)row * D : cc + (size_t)(row - MLAT) * D; float* db = (rowb < MLAT) ? cl + (size_t)rowb * D : cc + (size_t)(rowb - MLAT) * D;
#pragma unroll
            for (int j = 0; j < 4; ++j) { *(f32x4*)(da + 4 * (lane + 64 * j)) = va[j]; if (two) *(f32x4*)(db + 4 * (lane + 64 * j)) = vb[j]; } }
#pragma unroll
        for (int half = 0; half < 2; ++half) { const int rw = half ? rowb : row; if (half && !two) break;
            const int r = (rw < MLAT) ? (rw >> 13) : 8;
            if (r != rcur) { rcur = r; const float* mr = mod + (size_t)r * 6144;
#pragma unroll
                for (int j = 0; j < 4; ++j) { const int col = 4 * (lane + 64 * j); const f32x4 g4 = *(const f32x4*)(g + col), sc = *(const f32x4*)(mr + isc * 1024 + col); ca[j] = g4 * (sc + 1.f); cb[j] = *(const f32x4*)(mr + ish * 1024 + col); } }
            const float rs = half ? rsb : rsa;
#pragma unroll
            for (int j = 0; j < 4; ++j) { const int col = 4 * (lane + 64 * j); const f32x4 y = ((half ? vb[j] : va[j]) * rs) * ca[j] + cb[j];
                u32x2 o; o.x = cvt_pk_bf16(y[0], y[1]); o.y = cvt_pk_bf16(y[2], y[3]);
                *(u32x2*)(H + (size_t)rw * D + col) = o; } }
    }
}
__device__ __forceinline__ void phase_final(float* x, const float* g, int wave, int lane) {
    const int gw = blockIdx.x * 8 + wave, NGW = gridDim.x * 8;
    for (int row = gw; row < MLAT; row += NGW) {
        float* src = x + (size_t)row * D; f32x4 v[4]; float ss = 0.f;
#pragma unroll
        for (int j = 0; j < 4; ++j) { v[j] = *(const f32x4*)(src + 4 * (lane + 64 * j)); ss += (v[j][0] * v[j][0] + v[j][1] * v[j][1]) + (v[j][2] * v[j][2] + v[j][3] * v[j][3]); }
        const float rstd = __builtin_amdgcn_rsqf(wave_sum(ss) * (1.f / D) + RMS_EPS);
#pragma unroll
        for (int j = 0; j < 4; ++j) { const int col = 4 * (lane + 64 * j); f32x4 o = v[j] * rstd * *(const f32x4*)(g + col);
#ifdef DBG_SANITIZE
            for (int q = 0; q < 4; ++q) if (!(fabsf(o[q]) < 1e30f)) o[q] = 777.f;
#endif
            *(f32x4*)(src + col) = o; }
    }
}

__device__ __forceinline__ void panel_norm(float* x, const float* g, const float* mod  , int ish, int isc, bf16_t* H, int colmajor, int mode, int wave, int lane) {
    for (int pm = blockIdx.x; pm < 256; pm += gridDim.x) {
        const int r = pm >> 5; f32x4 ca[4], cb[4];
#pragma unroll
        for (int j = 0; j < 4; ++j) { const int col = 4 * (lane + 64 * j); const f32x4 g4 = *(const f32x4*)(g + col);
            if (mode == 0) { const float* mr = mod + (size_t)r * 6144; ca[j] = g4 * (*(const f32x4*)(mr + isc * 1024 + col) + 1.f); cb[j] = *(const f32x4*)(mr + ish * 1024 + col); }
            else { ca[j] = g4; cb[j] = (f32x4){0.f, 0.f, 0.f, 0.f}; } }
#pragma unroll 1
        for (int i = 0; i < 32; i += 2) {
            int ra = pm * 256 + wave * 32 + i, rb = ra + 1;
            if (colmajor) { const int ta = ra & 8191, tb = rb & 8191; ra = (ra & ~8191) + (ta & 127) * 64 + (ta >> 7); rb = (rb & ~8191) + (tb & 127) * 64 + (tb >> 7); }
            float* pa = x + (size_t)ra * D; float* pb = x + (size_t)rb * D;
            f32x4 va[4], vb[4]; float sa = 0.f, sb = 0.f;
#pragma unroll
            for (int j = 0; j < 4; ++j) { va[j] = *(const f32x4*)(pa + 4 * (lane + 64 * j)); vb[j] = *(const f32x4*)(pb + 4 * (lane + 64 * j)); }
#pragma unroll
            for (int j = 0; j < 4; ++j) { sa += (va[j][0] * va[j][0] + va[j][1] * va[j][1]) + (va[j][2] * va[j][2] + va[j][3] * va[j][3]); sb += (vb[j][0] * vb[j][0] + vb[j][1] * vb[j][1]) + (vb[j][2] * vb[j][2] + vb[j][3] * vb[j][3]); }
            sa = wave_sum(sa); sb = wave_sum(sb);
            const float rsa = __builtin_amdgcn_rsqf(sa * (1.f / D) + RMS_EPS), rsb = __builtin_amdgcn_rsqf(sb * (1.f / D) + RMS_EPS);
#pragma unroll
            for (int j = 0; j < 4; ++j) { const int col = 4 * (lane + 64 * j); const f32x4 ya = (va[j] * rsa) * ca[j] + cb[j], yb = (vb[j] * rsb) * ca[j] + cb[j];
                if (mode == 0) { u32x2 o; o.x = cvt_pk_bf16(ya[0], ya[1]); o.y = cvt_pk_bf16(ya[2], ya[3]); *(u32x2*)(H + (size_t)ra * D + col) = o;
                                 u32x2 q; q.x = cvt_pk_bf16(yb[0], yb[1]); q.y = cvt_pk_bf16(yb[2], yb[3]); *(u32x2*)(H + (size_t)rb * D + col) = q; }
                else { *(f32x4*)(pa + col) = ya; *(f32x4*)(pb + col) = yb; } } }
    }
}
struct PanelOrder {
    int c, G, npan, nctx;
    __device__ void init(int G_, int c_, int nctx_) { G = G_; c = c_; nctx = nctx_; npan = (c < 256) ? (256 - c + G - 1) / G : 0; }
    __device__ bool next(int i, pg8::Unit& u) const {
        if (i < 4 * npan) { u.pm = c + (i >> 2) * G; u.pn = i & 3; return true; }
        const int j = c + (i - 4 * npan) * G; if (j >= nctx) return false;
        u.pm = 256 + (j >> 2); u.pn = j & 3; return true; }
    __device__ __forceinline__ void a_ready(const pg8::Unit&) const {}
    __device__ __forceinline__ void done(const pg8::Unit&) const {}
};

__device__ __forceinline__ void phase_final_bf16(const bf16_t* X, const float* part, float* out, const float* g, int wave, int lane) {
    const int gw = blockIdx.x * 8 + wave, NGW = gridDim.x * 8;
    f32x4 gg[4];
#pragma unroll
    for (int j = 0; j < 4; ++j) gg[j] = *(const f32x4*)(g + 4 * lane + 256 * j);
#pragma unroll 1
    for (int row = gw; row < MLAT; row += 2 * NGW) { const bool two = (row + NGW < MLAT); const int rowb = two ? row + NGW : row;
        uint2 a[4], b[4];
#pragma unroll
        for (int j = 0; j < 4; ++j) { a[j] = *(const uint2*)(X + (size_t)row * D + 4 * lane + 256 * j); b[j] = *(const uint2*)(X + (size_t)rowb * D + 4 * lane + 256 * j); }
        const float pa = (lane < 16) ? part[(size_t)row * 16 + lane] : 0.f, pb = (lane < 16) ? part[(size_t)rowb * 16 + lane] : 0.f;
        const float rsa = __builtin_amdgcn_rsqf(wave_sum(pa) * (1.f / D) + RMS_EPS), rsb = __builtin_amdgcn_rsqf(wave_sum(pb) * (1.f / D) + RMS_EPS);
#pragma unroll
        for (int j = 0; j < 4; ++j) { float xa[4], xb[4]; unpack4(a[j], xa); unpack4(b[j], xb);
            *(f32x4*)(out + (size_t)row * D + 4 * lane + 256 * j) = (f32x4){xa[0], xa[1], xa[2], xa[3]} * rsa * gg[j];
            if (two) *(f32x4*)(out + (size_t)rowb * D + 4 * lane + 256 * j) = (f32x4){xb[0], xb[1], xb[2], xb[3]} * rsb * gg[j]; } }
}
struct EpiNull { static constexpr bool PERM = true, AFTER_DRAIN = false; float* sink;
    __device__ __forceinline__ void operator()(const f32x4 (&acc)[2][2][4][2], const pg8::Unit& u, int wr, int wc, int fr, int fq) const { f32x4 s = {0.f, 0.f, 0.f, 0.f};
#pragma unroll
        for (int a = 0; a < 2; ++a)
#pragma unroll
            for (int b = 0; b < 2; ++b)
#pragma unroll
                for (int m = 0; m < 4; ++m)
#pragma unroll
                    for (int n = 0; n < 2; ++n) s += acc[a][b][m][n];
        if (s[0] + s[1] + s[2] + s[3] == 123456.789f) sink[fr] = s[0]; } };
struct EpiProj {
    static constexpr bool PERM = true, AFTER_DRAIN = false;
    bf16_t* O; float* gates; int colmajor;
    __device__ __forceinline__ void operator()(const f32x4 (&acc)[2][2][4][2], const pg8::Unit& u, int wr, int wc, int fr, int fq) const {
        const int col0 = u.pn * 256 + wc * 32 + 8 * fq; const bool gt = (u.pn == 6) || (u.pn == 12);
#pragma unroll
        for (int ai = 0; ai < 2; ++ai)
#pragma unroll
            for (int m = 0; m < 4; ++m) { const int r = u.pm * 256 + ai * 128 + wr * 64 + m * 16 + fr; int dr = r;
                if (colmajor && r < MLAT) { const int rho = r & 8191; dr = (r & ~8191) + (rho & 63) * 128 + (rho >> 6); }
                bf16_t* rowp = O + (size_t)dr * NINP + col0;
#pragma unroll
                for (int bj = 0; bj < 2; ++bj) { const f32x4 v0 = acc[ai][bj][m][0], v1 = acc[ai][bj][m][1];
                    u32x4 w; w.x = cvt_pk_bf16(v0[0], v0[1]); w.y = cvt_pk_bf16(v0[2], v0[3]); w.z = cvt_pk_bf16(v1[0], v1[1]); w.w = cvt_pk_bf16(v1[2], v1[3]);
                    *(u32x4*)(rowp + bj * 128) = w;
                    if (gt) { const int c = col0 + bj * 128;
                        if (c >= 1536 && c < 1552) { float* gp = gates + (size_t)dr * 48 + (c - 1536); *(f32x4*)gp = v0; *(f32x4*)(gp + 4) = v1; }
                        else if (c >= 3216 && c < 3248) { float* gp = gates + (size_t)dr * 48 + 16 + (c - 3216); *(f32x4*)gp = v0; *(f32x4*)(gp + 4) = v1; } } } }
    }
};
struct EpiRes {
    static constexpr bool PERM = false, AFTER_DRAIN = false;
    float* xlat; float* xctx; const float* gmod; int colmajor;
    __device__ __forceinline__ void operator()(const f32x4 (&acc)[2][2][4][2], const pg8::Unit& u, int wr, int wc, int fr, int fq) const {
        const int col0 = u.pn * 256 + wc * 32 + 4 * fq; const int rmod = (u.pm < 256) ? (u.pm >> 5) : 8;
        f32x4 gv[2][2];
#pragma unroll
        for (int bj = 0; bj < 2; ++bj)
#pragma unroll
            for (int n = 0; n < 2; ++n) gv[bj][n] = *(const f32x4*)(gmod + (size_t)rmod * 6144 + col0 + bj * 128 + n * 16);
#pragma unroll
        for (int ai = 0; ai < 2; ++ai) {
            float* rp[4]; f32x4 xv[4][2][2];
#pragma unroll
            for (int m = 0; m < 4; ++m) { const int r = u.pm * 256 + ai * 128 + wr * 64 + m * 16 + fr;
                if (r < MLAT) { int dr = r; if (colmajor) { const int tp = r & 8191; dr = (r & ~8191) + (tp & 127) * 64 + (tp >> 7); } rp[m] = xlat + (size_t)dr * D + col0; }
                else rp[m] = xctx + (size_t)(r - MLAT) * D + col0; }
#pragma unroll
            for (int m = 0; m < 4; ++m)
#pragma unroll
                for (int bj = 0; bj < 2; ++bj)
#pragma unroll
                    for (int n = 0; n < 2; ++n) xv[m][bj][n] = *(const f32x4*)(rp[m] + bj * 128 + n * 16);
#pragma unroll
            for (int m = 0; m < 4; ++m)
#pragma unroll
                for (int bj = 0; bj < 2; ++bj)
#pragma unroll
                    for (int n = 0; n < 2; ++n) *(f32x4*)(rp[m] + bj * 128 + n * 16) = xv[m][bj][n] + gv[bj][n] * acc[ai][bj][m][n];
            asm volatile("" ::: "memory"); }
    }
};
struct EpiFfn {
    static constexpr bool PERM = true, AFTER_DRAIN = false;
    bf16_t* Hd;
    __device__ __forceinline__ void operator()(const f32x4 (&acc)[2][2][4][2], const pg8::Unit& u, int wr, int wc, int fr, int fq) const {
        const int col0 = u.pn * 128 + wc * 32 + 8 * fq;
#pragma unroll
        for (int ai = 0; ai < 2; ++ai)
#pragma unroll
            for (int m = 0; m < 4; ++m) { const int r = u.pm * 256 + ai * 128 + wr * 64 + m * 16 + fr;
                const f32x4 g0 = acc[ai][0][m][0], g1 = acc[ai][0][m][1], u0 = acc[ai][1][m][0], u1 = acc[ai][1][m][1];
                u32x4 w; w.x = cvt_pk_bf16(silu_(g0[0]) * u0[0], silu_(g0[1]) * u0[1]); w.y = cvt_pk_bf16(silu_(g0[2]) * u0[2], silu_(g0[3]) * u0[3]);
                w.z = cvt_pk_bf16(silu_(g1[0]) * u1[0], silu_(g1[1]) * u1[1]); w.w = cvt_pk_bf16(silu_(g1[2]) * u1[2], silu_(g1[3]) * u1[3]);
                *(u32x4*)(Hd + (size_t)r * DFF + col0) = w; }
    }
};

__device__ __forceinline__ float row_rstd(const float* part, int row) {
    const f32x4 a = *(const f32x4*)(part + (size_t)row * 16), b = *(const f32x4*)(part + (size_t)row * 16 + 4), c = *(const f32x4*)(part + (size_t)row * 16 + 8), d = *(const f32x4*)(part + (size_t)row * 16 + 12);
    const float s = ((a[0] + a[1]) + (a[2] + a[3])) + ((b[0] + b[1]) + (b[2] + b[3])) + ((c[0] + c[1]) + (c[2] + c[3])) + ((d[0] + d[1]) + (d[2] + d[3]));
    return __builtin_amdgcn_rsqf(s * (1.f / D) + RMS_EPS);
}
__device__ __forceinline__ void wave_rstd_table(const float* part, int row0  , int lane, LAS float* tab) {
    const float* pa = part + (size_t)(row0 + lane) * 16; const float* pb = part + (size_t)(row0 + 128 + lane) * 16;
    f32x4 a[4], b[4];
#pragma unroll
    for (int q = 0; q < 4; ++q) { a[q] = *(const f32x4*)(pa + 4 * q); b[q] = *(const f32x4*)(pb + 4 * q); }
    const f32x4 sa = (a[0] + a[1]) + (a[2] + a[3]), sb = (b[0] + b[1]) + (b[2] + b[3]);
    tab[lane] = __builtin_amdgcn_rsqf(((sa[0] + sa[1]) + (sa[2] + sa[3])) * (1.f / D) + RMS_EPS); tab[64 + lane] = __builtin_amdgcn_rsqf(((sb[0] + sb[1]) + (sb[2] + sb[3])) * (1.f / D) + RMS_EPS);
    asm volatile("s_waitcnt lgkmcnt(0)" ::: "memory");
}
struct EpiProjN {
    static constexpr bool PERM = true, AFTER_DRAIN = false;
    bf16_t* O; float* gates; int colmajor; const float* part; const float* shw  ; LAS float* tabs;
    __device__ __forceinline__ void operator()(const f32x4 (&acc)[2][2][4][2], const pg8::Unit& u, int wr, int wc, int fr, int fq) const {
        const int col0 = u.pn * 256 + wc * 32 + 8 * fq; const bool gt = (u.pn == 6) || (u.pn == 12); const int rmod = (u.pm < 256) ? (u.pm >> 5) : 8;
        f32x4 bs[2][2];
#pragma unroll
        for (int bj = 0; bj < 2; ++bj)
#pragma unroll
            for (int n = 0; n < 2; ++n) bs[bj][n] = *(const f32x4*)(shw + (size_t)rmod * NINP + col0 + bj * 128 + 4 * n);
        LAS float* tab = tabs + (wr * 4 + wc) * 128; wave_rstd_table(part, u.pm * 256 + wr * 64, fq * 16 + fr, tab);
#pragma unroll
        for (int ai = 0; ai < 2; ++ai)
#pragma unroll
            for (int m = 0; m < 4; ++m) { const int r = u.pm * 256 + ai * 128 + wr * 64 + m * 16 + fr; int dr = r;
                if (colmajor && r < MLAT) { const int rho = r & 8191; dr = (r & ~8191) + (rho & 63) * 128 + (rho >> 6); }
                const float rs = tab[ai * 64 + m * 16 + fr];
                bf16_t* rowp = O + (size_t)dr * NINP + col0;
#pragma unroll
                for (int bj = 0; bj < 2; ++bj) { const f32x4 v0 = acc[ai][bj][m][0] * rs + bs[bj][0], v1 = acc[ai][bj][m][1] * rs + bs[bj][1];
                    u32x4 w; w.x = cvt_pk_bf16(v0[0], v0[1]); w.y = cvt_pk_bf16(v0[2], v0[3]); w.z = cvt_pk_bf16(v1[0], v1[1]); w.w = cvt_pk_bf16(v1[2], v1[3]);
                    *(u32x4*)(rowp + bj * 128) = w;
                    if (gt) { const int c = col0 + bj * 128;
                        if (c >= 1536 && c < 1552) { float* gp = gates + (size_t)dr * 48 + (c - 1536); *(f32x4*)gp = v0; *(f32x4*)(gp + 4) = v1; }
                        else if (c >= 3216 && c < 3248) { float* gp = gates + (size_t)dr * 48 + 16 + (c - 3216); *(f32x4*)gp = v0; *(f32x4*)(gp + 4) = v1; } } } }
    }
};
struct EpiResN {
    static constexpr bool PERM = false, AFTER_DRAIN = false;
    float* xlat; float* xctx; const float* gmod; int colmajor; bf16_t* Hn  ; const float* gmn  ; float* part; const float* rlat; const float* rctx; int last;
    __device__ __forceinline__ void operator()(const f32x4 (&acc)[2][2][4][2], const pg8::Unit& u, int wr, int wc, int fr, int fq) const {
        const int col0 = u.pn * 256 + wc * 32 + 4 * fq; const int rmod = (u.pm < 256) ? (u.pm >> 5) : 8;
        f32x4 gv[2][2], gn[2][2];
#pragma unroll
        for (int bj = 0; bj < 2; ++bj)
#pragma unroll
            for (int n = 0; n < 2; ++n) { gv[bj][n] = *(const f32x4*)(gmod + (size_t)rmod * 6144 + col0 + bj * 128 + n * 16);
                gn[bj][n] = Hn ? *(const f32x4*)(gmn + (size_t)rmod * 1024 + col0 + bj * 128 + n * 16) : (f32x4){0.f, 0.f, 0.f, 0.f}; }
#pragma unroll
        for (int ai = 0; ai < 2; ++ai)
#pragma unroll
            for (int mp = 0; mp < 2; ++mp) {
                float* rp[2]; const float* rq[2]; int drs[2]; f32x4 xv[2][2][2];
#pragma unroll
                for (int mm = 0; mm < 2; ++mm) { const int m = 2 * mp + mm; const int r = u.pm * 256 + ai * 128 + wr * 64 + m * 16 + fr; int dr = r;
                    if (r < MLAT) { if (colmajor) { const int tp = r & 8191; dr = (r & ~8191) + (tp & 127) * 64 + (tp >> 7); } rp[mm] = xlat + (size_t)dr * D + col0; rq[mm] = rlat + (size_t)dr * D + col0; }
                    else { rp[mm] = xctx + (size_t)(r - MLAT) * D + col0; rq[mm] = rctx + (size_t)(r - MLAT) * D + col0; }
                    drs[mm] = dr; }
#pragma unroll
                for (int mm = 0; mm < 2; ++mm)
#pragma unroll
                    for (int bj = 0; bj < 2; ++bj)
#pragma unroll
                        for (int n = 0; n < 2; ++n) xv[mm][bj][n] = *(const f32x4*)(rq[mm] + bj * 128 + n * 16);
#pragma unroll
                for (int mm = 0; mm < 2; ++mm) { const int m = 2 * mp + mm; float ss = 0.f;
#pragma unroll
                    for (int bj = 0; bj < 2; ++bj)
#pragma unroll
                        for (int n = 0; n < 2; ++n) { const f32x4 v = xv[mm][bj][n] + gv[bj][n] * acc[ai][bj][m][n]; if (!last) *(f32x4*)(rp[mm] + bj * 128 + n * 16) = v;
                            if (Hn) { ss += (v[0] * v[0] + v[1] * v[1]) + (v[2] * v[2] + v[3] * v[3]); const f32x4 y = last ? v : v * gn[bj][n];
                                u32x2 o; o.x = cvt_pk_bf16(y[0], y[1]); o.y = cvt_pk_bf16(y[2], y[3]); *(u32x2*)(Hn + (size_t)drs[mm] * D + col0 + bj * 128 + n * 16) = o; } }
                    if (Hn) { ss += __shfl_xor(ss, 16); ss += __shfl_xor(ss, 32); if (fq == 0) part[(size_t)drs[mm] * 16 + u.pn * 4 + wc] = ss; } }
                asm volatile("" ::: "memory"); }
    }
};
struct EpiFfnN {
    static constexpr bool PERM = true, AFTER_DRAIN = false;
    bf16_t* Hd; const float* part; const float* shw  ; LAS float* tabs;
    __device__ __forceinline__ void operator()(const f32x4 (&acc)[2][2][4][2], const pg8::Unit& u, int wr, int wc, int fr, int fq) const {
        const int col0 = u.pn * 128 + wc * 32 + 8 * fq, bcol = u.pn * 256 + wc * 32 + 8 * fq; const int rmod = (u.pm < 256) ? (u.pm >> 5) : 8;
        f32x4 bs[2][2];
#pragma unroll
        for (int bj = 0; bj < 2; ++bj)
#pragma unroll
            for (int n = 0; n < 2; ++n) bs[bj][n] = *(const f32x4*)(shw + (size_t)rmod * 5632 + bcol + bj * 128 + 4 * n);
        const f32x4 bsn[2] = {bs[0][0] * -1.4426950408889634f, bs[0][1] * -1.4426950408889634f};
        LAS float* tab = tabs + (wr * 4 + wc) * 128; wave_rstd_table(part, u.pm * 256 + wr * 64, fq * 16 + fr, tab);
#pragma unroll
        for (int ai = 0; ai < 2; ++ai)
#pragma unroll
            for (int m = 0; m < 4; ++m) { const int r = u.pm * 256 + ai * 128 + wr * 64 + m * 16 + fr; const float rs = tab[ai * 64 + m * 16 + fr];
                const f32x4 g0 = acc[ai][0][m][0] * rs + bs[0][0], g1 = acc[ai][0][m][1] * rs + bs[0][1], u0 = acc[ai][1][m][0] * rs + bs[1][0], u1 = acc[ai][1][m][1] * rs + bs[1][1];
                const float rsn = rs * -1.4426950408889634f;
                const f32x4 e0 = acc[ai][0][m][0] * rsn + bsn[0], e1 = acc[ai][0][m][1] * rsn + bsn[1];
                f32x4 h0, h1;
#pragma unroll
                for (int j = 0; j < 4; ++j) { h0[j] = (g0[j] * u0[j]) * __builtin_amdgcn_rcpf(1.f + __builtin_amdgcn_exp2f(e0[j])); h1[j] = (g1[j] * u1[j]) * __builtin_amdgcn_rcpf(1.f + __builtin_amdgcn_exp2f(e1[j])); }
                u32x4 w; w.x = cvt_pk_bf16(h0[0], h0[1]); w.y = cvt_pk_bf16(h0[2], h0[3]); w.z = cvt_pk_bf16(h1[0], h1[1]); w.w = cvt_pk_bf16(h1[2], h1[3]);
                *(u32x4*)(Hd + (size_t)r * DFF + col0) = w; }
    }
};

__device__ __forceinline__ void phase_first(CParams& P, LAS unsigned char* lds, int tid, int wave, int lane) {
    const float* MOD = (const float*)(P.ws + WS_MOD); float* GM = (float*)(P.ws + WS_GM);
    float* XCTX = (float*)(P.ws + WS_XCTX); bf16_t* H = (bf16_t*)(P.ws + WS_HY); float* PARTA = (float*)(P.ws + WS_PARTA);
    const int gw = blockIdx.x * 8 + wave, NGW = gridDim.x * 8;
    for (int i = blockIdx.x * 512 + tid; i < 4 * 2 * 9 * 1024; i += gridDim.x * 512) { const int col = i & 1023, r = (i >> 10) % 9, lw = i / 9216, l = lw >> 1, which = lw & 1;
        GM[i] = (which ? P.in[5] : P.in[4])[l * 1024 + col] * (1.f + MOD[(size_t)(l * 9 + r) * 6144 + (which ? 4 : 1) * 1024 + col]); }
#pragma unroll 1
    for (int part = 0; part < 2; ++part) {
      if ((part ^ (int)(blockIdx.x & 1)) == 0) {
    { const int rpw = (MTOT + NGW - 1) / NGW, r0 = gw * rpw, r1 = (r0 + rpw < MTOT) ? r0 + rpw : MTOT; f32x4 ca[4]; int rcur = -1;
      for (int row = r0; row < r1; ++row) {
          const float* src = (row < MLAT) ? P.in[0] + (size_t)row * D : P.in[2] + (size_t)(row - MLAT) * D;
          const int r = (row < MLAT) ? (row >> 13) : 8;
          if (r != rcur) { rcur = r;
#pragma unroll
              for (int j = 0; j < 4; ++j) { const int col = 4 * (lane + 64 * j); ca[j] = *(const f32x4*)(P.in[4] + col) * (*(const f32x4*)(MOD + (size_t)r * 6144 + 1024 + col) + 1.f); } }
          f32x4 v[4]; float ss = 0.f;
#pragma unroll
          for (int j = 0; j < 4; ++j) { v[j] = *(const f32x4*)(src + 4 * (lane + 64 * j)); ss += (v[j][0] * v[j][0] + v[j][1] * v[j][1]) + (v[j][2] * v[j][2] + v[j][3] * v[j][3]); }
          ss = wave_sum(ss);
#pragma unroll
          for (int j = 0; j < 4; ++j) { const int col = 4 * (lane + 64 * j); const f32x4 y = v[j] * ca[j];
              u32x2 o; o.x = cvt_pk_bf16(y[0], y[1]); o.y = cvt_pk_bf16(y[2], y[3]); *(u32x2*)(H + (size_t)row * D + col) = o; }
          if (lane < 16) PARTA[(size_t)row * 16 + lane] = (lane == 0) ? ss : 0.f; } }
      } else {
    LAS float* sh = (LAS float*)lds;
    for (int lw = 0; lw < 8; ++lw) { const int l = lw >> 1, which = lw & 1; const int N = which ? 5632 : NINP;
        const bf16_t* WT = which ? (const bf16_t*)(P.ws + WS_WFI) + (size_t)l * 5632 * 1024 : (const bf16_t*)(P.ws + WS_WIN) + (size_t)l * NINP * 1024;
        float* out = which ? (float*)(P.ws + WS_SHW2) + (size_t)l * 9 * 5632 : (float*)(P.ws + WS_SHW1) + (size_t)l * 9 * NINP;
        __syncthreads();
        for (int i = tid; i < 9 * 1024; i += 512) sh[i] = MOD[(size_t)(l * 9 + (i >> 10)) * 6144 + (which ? 3 : 0) * 1024 + (i & 1023)];
        __syncthreads();
        uint4 nx0 = {0u, 0u, 0u, 0u}, nx1 = {0u, 0u, 0u, 0u};
        if (gw < N) { nx0 = *(const uint4*)(WT + (size_t)gw * 1024 + 16 * lane); nx1 = *(const uint4*)(WT + (size_t)gw * 1024 + 16 * lane + 8); }
        for (int n = gw; n < N; n += NGW) { float w[16]; { float t8[8]; unpack8(nx0, t8);
#pragma unroll
                for (int j = 0; j < 8; ++j) w[j] = t8[j];
                unpack8(nx1, t8);
#pragma unroll
                for (int j = 0; j < 8; ++j) w[8 + j] = t8[j]; }
            if (n + NGW < N) { nx0 = *(const uint4*)(WT + (size_t)(n + NGW) * 1024 + 16 * lane); nx1 = *(const uint4*)(WT + (size_t)(n + NGW) * 1024 + 16 * lane + 8); }
            float res = 0.f;
#pragma unroll
            for (int r = 0; r < 9; ++r) { float a = 0.f;
#pragma unroll
                for (int q = 0; q < 4; ++q) { const f32x4 s4 = *(const LAS f32x4*)(sh + r * 1024 + 16 * lane + 4 * q); a += (s4[0] * w[4 * q] + s4[1] * w[4 * q + 1]) + (s4[2] * w[4 * q + 2] + s4[3] * w[4 * q + 3]); }
                a = wave_sum(a); if (lane == r) res = a; }
            if (lane < 9) out[(size_t)lane * N + n] = res; } }
      }
    }
}

struct UnitGeo { int rowbase, T, t0; };
__device__ __forceinline__ UnitGeo unit_geo(int b, int ci) { UnitGeo g; if (ci < 4) { g.rowbase = MLAT + b * 256 + ci * 64; g.T = 256; g.t0 = ci * 64; } else { g.rowbase = b * 8192 + (ci - 4) * 64; g.T = 8192; g.t0 = (ci - 4) * 64; } return g; }
constexpr int CONVW_OFF = 138240;

__device__ __forceinline__ void load_convw(CParams& P, LAS unsigned char* lds, int l, int tid) {
    LAS float* cw = (LAS float*)(lds + CONVW_OFF); const float* s = P.in[9] + l * 2304;
    for (int i = tid; i < 576; i += 512) *(LAS f32x4*)(cw + 4 * i) = *(const f32x4*)(s + 4 * i);
}
__device__ __forceinline__ void mlstm_gates(const float (&gi)[4], int lane, LAS float* GT) {
    const float lf = logsigmoid_(gi[1]), lb = logsigmoid_(gi[3]);
    const float bf = wave_incl_scan(lf, lane), ib_incl = wave_incl_scan(lb, lane);
    const float tot = lane63(ib_incl), rb = tot - ib_incl + lb;
    GT[lane] = bf; GT[64 + lane] = gi[0] - bf; GT[128 + lane] = rb; GT[192 + lane] = gi[2] - rb;
}
__device__ __forceinline__ void conv_silu8(const uint4 r0, const uint4 r1, const uint4 r2, const LAS float* cw, float scale, float (&y)[8]) {
    float x0[8], x1[8], x2[8]; unpack8(r0, x0); unpack8(r1, x1); unpack8(r2, x2);
    const f32x4 w0a = *(const LAS f32x4*)(cw), w0b = *(const LAS f32x4*)(cw + 4), w1a = *(const LAS f32x4*)(cw + 768), w1b = *(const LAS f32x4*)(cw + 772), w2a = *(const LAS f32x4*)(cw + 1536), w2b = *(const LAS f32x4*)(cw + 1540);
#pragma unroll
    for (int j = 0; j < 8; ++j) { const float w0 = j < 4 ? w0a[j & 3] : w0b[j & 3], w1 = j < 4 ? w1a[j & 3] : w1b[j & 3], w2 = j < 4 ? w2a[j & 3] : w2b[j & 3];
        y[j] = silu_(w0 * x0[j] + w1 * x1[j] + w2 * x2[j]) * scale; }
}
__device__ __forceinline__ void lds_st16(LAS bf16_t* p, const uint4 v) { const u32x4 t = {v.x, v.y, v.z, v.w}; *(LAS u32x4*)p = t; }
__device__ __forceinline__ int tsw(int r, int c) { return r * 72 + (c ^ (((r >> 3) & 7) << 3)); }
__device__ __forceinline__ void store_T8(LAS bf16_t* dst  , int stride, const uint4 raw) {
    const unsigned w4[4] = {raw.x, raw.y, raw.z, raw.w};
#pragma unroll
    for (int j = 0; j < 8; ++j) dst[j * stride] = (bf16_t)((j & 1) ? (w4[j >> 1] >> 16) : (w4[j >> 1] & 0xffffu));
}


struct UnitId { int b, h, ci; };
__device__ __forceinline__ UnitId unit_id(int v) { UnitId u; u.ci = v % NCH; const int bh = v / NCH; u.b = bh >> 2; u.h = bh & 3; return u; }

struct Ml1Regs { float gi[4]; uint4 kr[2][3], vr[2]; };
__device__ __forceinline__ void ml1_load(Ml1Regs& R, CParams& P, int l, const UnitId u, int tid, int wave, int lane) {
    const bf16_t* PROJ = (const bf16_t*)(P.ws + WS_PROJ); const float* GATES = (const float*)(P.ws + WS_GATES); const float* gbias = P.in[10] + l * 16;
    const UnitGeo ug = unit_geo(u.b, u.ci); const uint4 z4 = {0u, 0u, 0u, 0u};
#pragma unroll
    for (int q = 0; q < 4; ++q) R.gi[q] = 0.f;
    if (wave == 0) { const float* gr = GATES + (size_t)(ug.rowbase + lane) * 48;
#pragma unroll
        for (int q = 0; q < 4; ++q) R.gi[q] = gr[4 * q + u.h] + gbias[4 * q + u.h]; }
#pragma unroll
    for (int k = 0; k < 2; ++k) { const int it = tid + 512 * k; R.kr[k][0] = z4; R.kr[k][1] = z4; R.kr[k][2] = z4; R.vr[k] = z4;
        if (it < 768) { const int t = it / 12, v = it % 12, tt = ug.t0 + t; const bf16_t* p = PROJ + (size_t)(ug.rowbase + t) * NINP + 384 + u.h * 96 + v * 8;
            R.kr[k][1] = *(const uint4*)p; if (tt > 0) R.kr[k][0] = *(const uint4*)(p - NINP); if (tt < ug.T - 1) R.kr[k][2] = *(const uint4*)(p + NINP);
            R.vr[k] = *(const uint4*)(p + 384); } }
}
__device__ __forceinline__ void ml1_stage(const Ml1Regs& R, CParams& P, LAS unsigned char* lds, const UnitId u, int tid, int wave, int lane) {
    float* DECA = (float*)(P.ws + WS_DECA);
    LAS bf16_t* KT = (LAS bf16_t*)lds; LAS bf16_t* VT = (LAS bf16_t*)(lds + 13824); LAS float* GT = (LAS float*)(lds + 46080); LAS float* WF = (LAS float*)(lds + 47104);
    const LAS float* CW = (const LAS float*)(lds + CONVW_OFF);
    const int sidx0 = (u.b * 4 + u.h) * 2;
    if (wave == 0) {
        mlstm_gates(R.gi, lane, GT);
        asm volatile("s_waitcnt lgkmcnt(0)" ::: "memory");
        const float bfl = GT[63], rb0 = GT[128];
        WF[lane] = fexp_(bfl + GT[64 + lane]); WF[64 + lane] = fexp_(rb0 + GT[192 + lane]);
        if (lane == 0) { DECA[(sidx0 + 0) * NCH + u.ci] = fexp_(bfl); DECA[(sidx0 + 1) * NCH + u.ci] = fexp_(rb0); }
    }
#pragma unroll
    for (int k = 0; k < 2; ++k) { const int it = tid + 512 * k;
        if (it < 768) { const int t = it / 12, v = it % 12;
            float y[8]; conv_silu8(R.kr[k][0], R.kr[k][1], R.kr[k][2], CW + 384 + u.h * 96 + v * 8, 1.f, y);
#pragma unroll
            for (int j = 0; j < 8; ++j) KT[tsw(v * 8 + j, t)] = f2bf1(y[j]);
            store_T8(VT + tsw(v * 8, t), 72, R.vr[k]); } }
}
__device__ __forceinline__ void ml1_const(LAS unsigned char* lds, int tid) {
    LAS bf16_t* VT = (LAS bf16_t*)(lds + 13824);
    for (int it = tid; it < 16 * 64; it += 512) { const int e = 96 + (it >> 6), t = it & 63; VT[e * 72 + t] = (e == 96) ? (bf16_t)0x3f80 : (bf16_t)0; }
}
__device__ __forceinline__ bf16x8 scale_frag(const bf16x8 f, const LAS float* w) {
    union { bf16x8 b; uint4 u; } x; x.b = f; float v[8]; unpack8(x.u, v);
    const f32x4 wa = *(const LAS f32x4*)w, wb = *(const LAS f32x4*)(w + 4);
#pragma unroll
    for (int j = 0; j < 8; ++j) v[j] *= (j < 4 ? wa[j & 3] : wb[j & 3]);
    x.u = pack8(v); return x.b;
}
__device__ __forceinline__ void ml1_compute(CParams& P, LAS unsigned char* lds, const UnitId u, int wave, int lane) {
    bf16_t* STA = (bf16_t*)(P.ws + WS_STA);
    LAS bf16_t* KT = (LAS bf16_t*)lds; LAS bf16_t* VT = (LAS bf16_t*)(lds + 13824); const LAS float* WF = (const LAS float*)(lds + 47104);
    const int sidx0 = (u.b * 4 + u.h) * 2;
    const int dir = wave >> 2, l15 = lane & 15, quad = lane >> 4;
    bf16_t* dst = STA + ((size_t)(sidx0 + dir) * NCH + u.ci) * SA_SZ;
#pragma unroll
    for (int ei = 0; ei < 2; ++ei) { const int et = (wave & 3) + 4 * ei;
        if (et < 7) {
            bf16x8 vf[2];
#pragma unroll
            for (int ks = 0; ks < 2; ++ks) vf[ks] = scale_frag(LDSFRAG(VT + tsw(16 * et + l15, 32 * ks + 8 * quad)), WF + dir * 64 + 32 * ks + 8 * quad);
#pragma unroll
            for (int dt = 0; dt < 6; ++dt) { f32x4 acc = {0.f, 0.f, 0.f, 0.f};
#pragma unroll
                for (int ks = 0; ks < 2; ++ks) acc = MFMA16(LDSFRAG(KT + tsw(16 * dt + l15, 32 * ks + 8 * quad)), vf[ks], acc);
                const int e = 16 * et + l15;
                if (e <= 96) { u32x2 o; o.x = cvt_pk_bf16(acc[0], acc[1]); o.y = cvt_pk_bf16(acc[2], acc[3]); *(u32x2*)(dst + e * 96 + 16 * dt + 4 * quad) = o; } }
        } }
}

struct Ml3Regs { float gi[4]; uint4 qk[3][3], vr[2], cr[5]; };
__device__ __forceinline__ void ml3_load(Ml3Regs& R, CParams& P, int l, const UnitId u, int tid, int wave, int lane) {
    const bf16_t* PROJ = (const bf16_t*)(P.ws + WS_PROJ); const float* GATES = (const float*)(P.ws + WS_GATES); const bf16_t* STA = (const bf16_t*)(P.ws + WS_STA); const float* gbias = P.in[10] + l * 16;
    const UnitGeo ug = unit_geo(u.b, u.ci); const int sidx0 = (u.b * 4 + u.h) * 2; const uint4 z4 = {0u, 0u, 0u, 0u};
#pragma unroll
    for (int q = 0; q < 4; ++q) R.gi[q] = 0.f;
    if (wave == 0) { const float* gr = GATES + (size_t)(ug.rowbase + lane) * 48;
#pragma unroll
        for (int q = 0; q < 4; ++q) R.gi[q] = gr[4 * q + u.h] + gbias[4 * q + u.h]; }
#pragma unroll
    for (int k = 0; k < 3; ++k) { const int it = tid + 512 * k, which = it / 768, rem = it % 768, t = rem / 12, v = rem % 12, tt = ug.t0 + t;
        const bf16_t* p = PROJ + (size_t)(ug.rowbase + t) * NINP + which * 384 + u.h * 96 + v * 8;
        R.qk[k][0] = z4; R.qk[k][2] = z4; R.qk[k][1] = *(const uint4*)p; if (tt > 0) R.qk[k][0] = *(const uint4*)(p - NINP); if (tt < ug.T - 1) R.qk[k][2] = *(const uint4*)(p + NINP); }
#pragma unroll
    for (int k = 0; k < 2; ++k) { const int it = tid + 512 * k; R.vr[k] = z4;
        if (it < 768) { const int t = it / 12, v = it % 12; R.vr[k] = *(const uint4*)(PROJ + (size_t)(ug.rowbase + t) * NINP + 768 + u.h * 96 + v * 8); } }
#pragma unroll
    for (int k = 0; k < 5; ++k) { const int it = tid + 512 * k; R.cr[k] = z4;
        if (it < 2328) { const int dir = it / 1164, rem = it % 1164; R.cr[k] = *(const uint4*)(STA + ((size_t)(sidx0 + dir) * NCH + u.ci) * SA_SZ + rem * 8); } }
}
__device__ __forceinline__ void ml3_stage(const Ml3Regs& R, LAS unsigned char* lds, const UnitId u, int tid, int wave, int lane) {
    LAS bf16_t* Qs = (LAS bf16_t*)lds; LAS bf16_t* Ks = (LAS bf16_t*)(lds + 13312); LAS bf16_t* VT = (LAS bf16_t*)(lds + 26624); LAS bf16_t* Cs = (LAS bf16_t*)(lds + 42752);
    LAS float* GT = (LAS float*)(lds + 133376); const LAS float* CW = (const LAS float*)(lds + CONVW_OFF);
    const uint4 z4 = {0u, 0u, 0u, 0u};
    if (wave == 0) mlstm_gates(R.gi, lane, GT);
#pragma unroll
    for (int k = 0; k < 3; ++k) { const int it = tid + 512 * k, which = it / 768, rem = it % 768, t = rem / 12, v = rem % 12;
        float y[8]; conv_silu8(R.qk[k][0], R.qk[k][1], R.qk[k][2], CW + which * 384 + u.h * 96 + v * 8, which ? 1.f : 0.10206207262f, y);
        lds_st16((which ? Ks : Qs) + t * 104 + v * 8, pack8(y)); }
#pragma unroll
    for (int k = 0; k < 2; ++k) { const int it = tid + 512 * k; if (it < 768) { const int t = it / 12, v = it % 12; store_T8(VT + tsw(v * 8, t), 72, R.vr[k]); } }
#pragma unroll
    for (int k = 0; k < 5; ++k) { const int it = tid + 512 * k;
        if (it < 2328) { const int dir = it / 1164, rem = it % 1164, e = rem / 12, v = rem % 12; lds_st16(Cs + dir * 11648 + e * 104 + v * 8, R.cr[k]); } }
}
__device__ __forceinline__ void ml3_const(LAS unsigned char* lds, int tid) {
    LAS bf16_t* VT = (LAS bf16_t*)(lds + 26624); LAS bf16_t* Cs = (LAS bf16_t*)(lds + 42752); const uint4 z4 = {0u, 0u, 0u, 0u};
    for (int it = tid; it < 16 * 64; it += 512) { const int e = 96 + (it >> 6), t = it & 63; VT[e * 72 + t] = (e == 96) ? (bf16_t)0x3f80 : (bf16_t)0; }
    if (tid < 360) { const int dir = tid / 180, rem = tid % 180, e = 97 + rem / 12, v = rem % 12; lds_st16(Cs + dir * 11648 + e * 104 + v * 8, z4); }
}
__device__ __forceinline__ void ml3_compute(CParams& P, LAS unsigned char* lds, int l, const UnitId u, int wave, int lane) {
    const bf16_t* PROJ = (const bf16_t*)(P.ws + WS_PROJ); bf16_t* Y = (bf16_t*)(P.ws + WS_HY);
    LAS bf16_t* Qs = (LAS bf16_t*)lds; LAS bf16_t* Ks = (LAS bf16_t*)(lds + 13312); LAS bf16_t* VT = (LAS bf16_t*)(lds + 26624); LAS bf16_t* Cs = (LAS bf16_t*)(lds + 42752);
    LAS bf16_t* Sw = (LAS bf16_t*)(lds + 89344); LAS float* HB = (LAS float*)(lds + 107776); LAS float* GT = (LAS float*)(lds + 133376);
    const UnitGeo ug = unit_geo(u.b, u.ci); const float* ng = P.in[11] + l * 384 + u.h * 96;
    const int mt = wave & 3, dir = wave >> 2, l15 = lane & 15, quad = lane >> 4, t = 16 * mt + l15;
    const size_t row = (size_t)(ug.rowbase + t);
    uint2 oar[6];
    if (dir == 0) {
#pragma unroll
        for (int et = 0; et < 6; ++et) oar[et] = *(const uint2*)(PROJ + row * NINP + 1152 + u.h * 96 + 16 * et + 4 * quad);
    }
    bf16x8 qf[3];
#pragma unroll
    for (int ks = 0; ks < 3; ++ks) qf[ks] = LDSFRAG(Qs + t * 104 + 32 * ks + 8 * quad);
    const float bt = dir ? GT[128 + t] : GT[t];
    LAS bf16_t* Swr = Sw + wave * 1152 + l15 * 72;
    f32x4 sacc[4];
#pragma unroll
    for (int st = 0; st < 4; ++st) sacc[st] = (f32x4){0.f, 0.f, 0.f, 0.f};
#pragma unroll
    for (int ks = 0; ks < 3; ++ks)
#pragma unroll
        for (int st = 0; st < 4; ++st) sacc[st] = MFMA16(LDSFRAG(Ks + (16 * st + l15) * 104 + 32 * ks + 8 * quad), qf[ks], sacc[st]);
#pragma unroll
    for (int st = 0; st < 4; ++st) { const f32x4 acc = sacc[st];
        float val[4];
#pragma unroll
        for (int j = 0; j < 4; ++j) { const int s = 16 * st + 4 * quad + j; const float gs = dir ? GT[192 + s] : GT[64 + s]; const bool ok = dir ? (s >= t) : (s <= t);
            val[j] = ok ? acc[j] * fexp_(bt + gs) : 0.f; }
        u32x2 o; o.x = cvt_pk_bf16(val[0], val[1]); o.y = cvt_pk_bf16(val[2], val[3]); *(LAS u32x2*)(Swr + 16 * st + 4 * quad) = o; }
    asm volatile("s_waitcnt lgkmcnt(0)" ::: "memory");
    f32x4 a1[7];
#pragma unroll
    for (int et = 0; et < 7; ++et) a1[et] = (f32x4){0.f, 0.f, 0.f, 0.f};
#pragma unroll
    for (int ks = 0; ks < 2; ++ks) { const bf16x8 sf = LDSFRAG(Swr + 32 * ks + 8 * quad);
#pragma unroll
        for (int et = 0; et < 7; ++et) a1[et] = MFMA16(LDSFRAG(VT + tsw(16 * et + l15, 32 * ks + 8 * quad)), sf, a1[et]); }
    const float inter = fexp_(bt);
#pragma unroll
    for (int ks = 0; ks < 3; ++ks) { union { bf16x8 b; uint4 u; } x; x.b = qf[ks]; float qv[8]; unpack8(x.u, qv);
#pragma unroll
        for (int j = 0; j < 8; ++j) qv[j] *= inter;
        x.u = pack8(qv);
#pragma unroll
        for (int et = 0; et < 7; ++et) a1[et] = MFMA16(LDSFRAG(Cs + dir * 11648 + (16 * et + l15) * 104 + 32 * ks + 8 * quad), x.b, a1[et]); }
    const float den = __shfl(a1[6][0], l15);
    const float inv = __builtin_amdgcn_rcpf(fmaxf(fabsf(den), 1.f));
    if (dir == 1) {
#pragma unroll
        for (int et = 0; et < 6; ++et) *(LAS f32x4*)(HB + t * 100 + 16 * et + 4 * quad) = a1[et] * inv;
    }
    __syncthreads();
    if (dir == 0) { float ss = 0.f;
#pragma unroll
        for (int et = 0; et < 6; ++et) { a1[et] = a1[et] * inv + *(const LAS f32x4*)(HB + t * 100 + 16 * et + 4 * quad); ss += (a1[et][0] * a1[et][0] + a1[et][1] * a1[et][1]) + (a1[et][2] * a1[et][2] + a1[et][3] * a1[et][3]); }
        ss += __shfl_xor(ss, 16); ss += __shfl_xor(ss, 32);
        const float r = __builtin_amdgcn_rsqf(ss * (1.f / 96.f) + RMS_EPS);
#pragma unroll
        for (int et = 0; et < 6; ++et) { const int e = 16 * et + 4 * quad; const f32x4 g4 = *(const f32x4*)(ng + e);
            float oa[4]; unpack4(oar[et], oa);
            u32x2 o; o.x = cvt_pk_bf16(a1[et][0] * r * g4[0] * sigmoid_(oa[0]), a1[et][1] * r * g4[1] * sigmoid_(oa[1])); o.y = cvt_pk_bf16(a1[et][2] * r * g4[2] * sigmoid_(oa[2]), a1[et][3] * r * g4[3] * sigmoid_(oa[3]));
            *(u32x2*)(Y + row * D + u.h * 96 + e) = o; } }
}

struct Gl1Regs { uint4 kr, vr[2]; float wa[3][8]; f32x4 gb0, gb1, bias[3]; };
__device__ __forceinline__ void gl1_load_gate(Gl1Regs& R, CParams& P, int l, const UnitId u, int wave, int lane) {
    const float* GATES = (const float*)(P.ws + WS_GATES); const UnitGeo ug = unit_geo(u.b, u.ci);
    const float* wg = P.in[12] + (size_t)l * 2 * 16 * 192 + u.h * 48; const float* bg = P.in[13] + l * 2 * 192 + u.h * 48;
    const int dir = wave >> 2, mt = wave & 3, l15 = lane & 15, quad = lane >> 4;
    R.gb0 = (f32x4){0.f, 0.f, 0.f, 0.f}; R.gb1 = (f32x4){0.f, 0.f, 0.f, 0.f};
#pragma unroll
    for (int nt = 0; nt < 3; ++nt)
#pragma unroll
        for (int j = 0; j < 8; ++j) R.wa[nt][j] = (quad < 2) ? wg[(dir * 16 + 8 * quad + j) * 192 + 16 * nt + l15] : 0.f;
    if (quad < 2) { const float* gr = GATES + (size_t)(ug.rowbase + 16 * mt + l15) * 48 + 16 + dir * 16 + 8 * quad; R.gb0 = *(const f32x4*)gr; R.gb1 = *(const f32x4*)(gr + 4); }
#pragma unroll
    for (int nt = 0; nt < 3; ++nt) R.bias[nt] = *(const f32x4*)(bg + dir * 192 + 16 * nt + 4 * quad);
}
__device__ __forceinline__ void gl1_load_kv(Gl1Regs& R, CParams& P, const UnitId u, int tid) {
    const bf16_t* PROJ = (const bf16_t*)(P.ws + WS_PROJ); const UnitGeo ug = unit_geo(u.b, u.ci); const uint4 z4 = {0u, 0u, 0u, 0u};
    R.kr = z4;
    if (tid < 384) { const int s = tid / 6, v = tid % 6; R.kr = *(const uint4*)(PROJ + (size_t)(ug.rowbase + s) * NINP + 2256 + u.h * 48 + v * 8); }
#pragma unroll
    for (int k = 0; k < 2; ++k) { const int it = tid + 512 * k; R.vr[k] = z4;
        if (it < 768) { const int t = it / 12, v = it % 12; R.vr[k] = *(const uint4*)(PROJ + (size_t)(ug.rowbase + t) * NINP + 2448 + u.h * 96 + v * 8); } }
}
__device__ __forceinline__ void gl1_gate(const Gl1Regs& R, LAS unsigned char* lds, int wave, int lane) {
    LAS float* LA = (LAS float*)lds; const int dir = wave >> 2, mt = wave & 3, l15 = lane & 15, quad = lane >> 4;
    union { u32x4 u; bf16x8 b; } bfr; bfr.u.x = cvt_pk_bf16(R.gb0[0], R.gb0[1]); bfr.u.y = cvt_pk_bf16(R.gb0[2], R.gb0[3]); bfr.u.z = cvt_pk_bf16(R.gb1[0], R.gb1[1]); bfr.u.w = cvt_pk_bf16(R.gb1[2], R.gb1[3]);
#pragma unroll
    for (int nt = 0; nt < 3; ++nt) { union { u32x4 u; bf16x8 b; } afr; afr.u.x = cvt_pk_bf16(R.wa[nt][0], R.wa[nt][1]); afr.u.y = cvt_pk_bf16(R.wa[nt][2], R.wa[nt][3]); afr.u.z = cvt_pk_bf16(R.wa[nt][4], R.wa[nt][5]); afr.u.w = cvt_pk_bf16(R.wa[nt][6], R.wa[nt][7]);
        f32x4 acc = {0.f, 0.f, 0.f, 0.f}; acc = MFMA16(afr.b, bfr.b, acc);
        f32x4 la;
#pragma unroll
        for (int j = 0; j < 4; ++j) la[j] = logsigmoid_(acc[j] + R.bias[nt][j]) * 0.0625f;
        *(LAS f32x4*)(LA + (dir * 64 + 16 * mt + l15) * 48 + 16 * nt + 4 * quad) = la; }
}
__device__ __forceinline__ void gl1_scan(LAS unsigned char* lds, int wave, int lane) {
    LAS float* LA = (LAS float*)lds;
    const int dd = wave >> 2, d0 = (wave & 3) * 12; LAS float* p = LA + (dd * 64 + lane) * 48 + d0;
    float v[12];
#pragma unroll
    for (int c = 0; c < 12; ++c) v[c] = p[c];
#pragma unroll
    for (int c = 0; c < 12; ++c) { const float inc = wave_incl_scan(v[c], lane); p[c] = dd ? (lane63(inc) - inc + v[c]) : inc; }
}
__device__ __forceinline__ void gl1_stage(const Gl1Regs& R, CParams& P, LAS unsigned char* lds, const UnitId u, int tid) {
    float* DECC = (float*)(P.ws + WS_DECC); float* LAG = (float*)(P.ws + WS_LAG);
    LAS float* LA = (LAS float*)lds; LAS bf16_t* KH = (LAS bf16_t*)(lds + 24576); LAS bf16_t* VT = (LAS bf16_t*)(lds + 38400);
    const int sidx0 = (u.b * 4 + u.h) * 2;
    { float* lag = LAG + ((size_t)(u.b * 4 + u.h) * NCH + u.ci) * 6144;
#pragma unroll
      for (int k = 0; k < 3; ++k) { const int i4 = tid + 512 * k; *(f32x4*)(lag + 4 * i4) = *(const LAS f32x4*)(LA + 4 * i4); } }
    if (tid < 96) { const int dd = tid / 48, d = tid % 48; DECC[((size_t)(sidx0 + dd) * NCH + u.ci) * 48 + d] = fexp_(LA[(dd * 64 + (dd ? 0 : 63)) * 48 + d]); }
    if (tid < 384) { const int s = tid / 6, v = tid % 6; float x[8]; unpack8(R.kr, x);
#pragma unroll
        for (int j = 0; j < 8; ++j) { const int d = v * 8 + j;
            KH[tsw(d, s)] = f2bf1(x[j] * fexp_(LA[63 * 48 + d] - LA[s * 48 + d]));
            KH[3456 + tsw(d, s)] = f2bf1(x[j] * fexp_(LA[64 * 48 + d] - LA[(64 + s) * 48 + d])); } }
#pragma unroll
    for (int k = 0; k < 2; ++k) { const int it = tid + 512 * k; if (it < 768) { const int t = it / 12, v = it % 12; store_T8(VT + tsw(v * 8, t), 72, R.vr[k]); } }
}
__device__ __forceinline__ void gl1_compute(CParams& P, LAS unsigned char* lds, const UnitId u, int wave, int lane) {
    bf16_t* STC = (bf16_t*)(P.ws + WS_STC); LAS bf16_t* KH = (LAS bf16_t*)(lds + 24576); LAS bf16_t* VT = (LAS bf16_t*)(lds + 38400);
    const int sidx0 = (u.b * 4 + u.h) * 2, dir = wave >> 2, l15 = lane & 15, quad = lane >> 4;
    bf16_t* dst = STC + ((size_t)(sidx0 + dir) * NCH + u.ci) * SC_SZ;
#pragma unroll
    for (int ei = 0; ei < 2; ++ei) { const int et = (wave & 3) + 4 * ei;
        if (et < 6) {
            bf16x8 vf[2];
#pragma unroll
            for (int ks = 0; ks < 2; ++ks) vf[ks] = LDSFRAG(VT + tsw(16 * et + l15, 32 * ks + 8 * quad));
#pragma unroll
            for (int dt = 0; dt < 3; ++dt) { f32x4 acc = {0.f, 0.f, 0.f, 0.f};
#pragma unroll
                for (int ks = 0; ks < 2; ++ks) acc = MFMA16(LDSFRAG(KH + dir * 3456 + tsw(16 * dt + l15, 32 * ks + 8 * quad)), vf[ks], acc);
                u32x2 o; o.x = cvt_pk_bf16(acc[0], acc[1]); o.y = cvt_pk_bf16(acc[2], acc[3]); *(u32x2*)(dst + (16 * et + l15) * 48 + 16 * dt + 4 * quad) = o; }
        } }
}

struct Gl3Regs { uint4 xr[2], vr[2], sr[3]; f32x4 la[2][4]; };
__device__ __forceinline__ void gl3_load(Gl3Regs& R, CParams& P, const UnitId u, int tid) {
    const bf16_t* PROJ = (const bf16_t*)(P.ws + WS_PROJ); const bf16_t* STC = (const bf16_t*)(P.ws + WS_STC); const float* LAG = (const float*)(P.ws + WS_LAG);
    const UnitGeo ug = unit_geo(u.b, u.ci); const int sidx0 = (u.b * 4 + u.h) * 2;
    const float* lag = LAG + ((size_t)(u.b * 4 + u.h) * NCH + u.ci) * 6144; const uint4 z4 = {0u, 0u, 0u, 0u};
#pragma unroll
    for (int k = 0; k < 2; ++k) { const int it = tid + 512 * k; R.xr[k] = z4; R.vr[k] = z4;
#pragma unroll
        for (int q = 0; q < 4; ++q) R.la[k][q] = (f32x4){0.f, 0.f, 0.f, 0.f};
        if (it < 768) { const int which = it / 384, rem = it % 384, t = rem / 6, v = rem % 6;
            R.xr[k] = *(const uint4*)(PROJ + (size_t)(ug.rowbase + t) * NINP + 2064 + which * 192 + u.h * 48 + v * 8);
            R.la[k][0] = *(const f32x4*)(lag + t * 48 + v * 8); R.la[k][1] = *(const f32x4*)(lag + t * 48 + v * 8 + 4);
            R.la[k][2] = *(const f32x4*)(lag + 3072 + t * 48 + v * 8); R.la[k][3] = *(const f32x4*)(lag + 3072 + t * 48 + v * 8 + 4);
            const int t2 = it / 12, v2 = it % 12; R.vr[k] = *(const uint4*)(PROJ + (size_t)(ug.rowbase + t2) * NINP + 2448 + u.h * 96 + v2 * 8); } }
#pragma unroll
    for (int k = 0; k < 3; ++k) { const int it = tid + 512 * k; R.sr[k] = z4;
        if (it < 1152) { const int dd = it / 576, rem = it % 576; R.sr[k] = *(const uint4*)(STC + ((size_t)(sidx0 + dd) * NCH + u.ci) * SC_SZ + rem * 8); } }
}
__device__ __forceinline__ void gl3_stage(const Gl3Regs& R, LAS unsigned char* lds, int tid) {
    LAS bf16_t* QT = (LAS bf16_t*)lds; LAS bf16_t* KTl = (LAS bf16_t*)(lds + 18432); LAS bf16_t* VT = (LAS bf16_t*)(lds + 36864); LAS bf16_t* STs = (LAS bf16_t*)(lds + 50688);
    const uint4 z4 = {0u, 0u, 0u, 0u};
#pragma unroll
    for (int k = 0; k < 2; ++k) { const int it = tid + 512 * k;
        if (it < 768) { const int which = it / 384, rem = it % 384, t = rem / 6, v = rem % 6;
            float x[8], y0[8], y1[8]; unpack8(R.xr[k], x);
#pragma unroll
            for (int j = 0; j < 8; ++j) { const float a0 = j < 4 ? R.la[k][0][j & 3] : R.la[k][1][j & 3], a1 = j < 4 ? R.la[k][2][j & 3] : R.la[k][3][j & 3];
                if (which == 0) { y0[j] = x[j] * 0.14433756730f * fexp_(a0); y1[j] = x[j] * 0.14433756730f * fexp_(a1); } else { y0[j] = x[j] * fexp_(-a0); y1[j] = x[j] * fexp_(-a1); } }
            LAS bf16_t* dstp = which ? KTl : QT;
            lds_st16(dstp + t * 72 + v * 8, pack8(y0)); lds_st16(dstp + 4608 + t * 72 + v * 8, pack8(y1));
            const int t2 = it / 12, v2 = it % 12; store_T8(VT + tsw(v2 * 8, t2), 72, R.vr[k]); } }
#pragma unroll
    for (int k = 0; k < 3; ++k) { const int it = tid + 512 * k;
        if (it < 1152) { const int dd = it / 576, rem = it % 576, e = rem / 6, v = rem % 6; lds_st16(STs + dd * 6912 + e * 72 + v * 8, R.sr[k]); } }
}
__device__ __forceinline__ void gl3_const(LAS unsigned char* lds, int tid) {
    LAS bf16_t* QT = (LAS bf16_t*)lds; LAS bf16_t* STs = (LAS bf16_t*)(lds + 50688); const uint4 z4 = {0u, 0u, 0u, 0u};
    { const int arr = tid >> 7, t = (tid >> 1) & 63, v = tid & 1; lds_st16(QT + arr * 4608 + t * 72 + 48 + v * 8, z4); }
    if (tid < 384) { const int dd = tid / 192, rem = tid % 192, e = rem >> 1, v = 6 + (rem & 1); lds_st16(STs + dd * 6912 + e * 72 + v * 8, z4); }
}
__device__ __forceinline__ void gl3_compute(CParams& P, LAS unsigned char* lds, int l, const UnitId u, int wave, int lane) {
    const bf16_t* PROJ = (const bf16_t*)(P.ws + WS_PROJ); bf16_t* Y = (bf16_t*)(P.ws + WS_HY);
    LAS bf16_t* QT = (LAS bf16_t*)lds; LAS bf16_t* KTl = (LAS bf16_t*)(lds + 18432); LAS bf16_t* VT = (LAS bf16_t*)(lds + 36864); LAS bf16_t* STs = (LAS bf16_t*)(lds + 50688);
    LAS bf16_t* Sw = (LAS bf16_t*)(lds + 78336); LAS float* HB = (LAS float*)(lds + 96768);
    const UnitGeo ug = unit_geo(u.b, u.ci); const float* ng = P.in[14] + l * 96;
    const int mt = wave & 3, dir = wave >> 2, l15 = lane & 15, quad = lane >> 4, t = 16 * mt + l15;
    const size_t row = (size_t)(ug.rowbase + t);
    uint2 gcr[6];
    if (dir == 0) {
#pragma unroll
        for (int et = 0; et < 6; ++et) gcr[et] = *(const uint2*)(PROJ + row * NINP + 2832 + u.h * 96 + 16 * et + 4 * quad);
    }
    bf16x8 qf[2];
#pragma unroll
    for (int ks = 0; ks < 2; ++ks) qf[ks] = LDSFRAG(QT + dir * 4608 + t * 72 + 32 * ks + 8 * quad);
    LAS bf16_t* Swr = Sw + wave * 1152 + l15 * 72;
    f32x4 sacc[4];
#pragma unroll
    for (int st = 0; st < 4; ++st) sacc[st] = (f32x4){0.f, 0.f, 0.f, 0.f};
#pragma unroll
    for (int ks = 0; ks < 2; ++ks)
#pragma unroll
        for (int st = 0; st < 4; ++st) sacc[st] = MFMA16(LDSFRAG(KTl + dir * 4608 + (16 * st + l15) * 72 + 32 * ks + 8 * quad), qf[ks], sacc[st]);
#pragma unroll
    for (int st = 0; st < 4; ++st) { const f32x4 acc = sacc[st];
        float val[4];
#pragma unroll
        for (int j = 0; j < 4; ++j) { const int s = 16 * st + 4 * quad + j; const bool ok = dir ? (s >= t) : (s <= t); val[j] = ok ? acc[j] : 0.f; }
        u32x2 o; o.x = cvt_pk_bf16(val[0], val[1]); o.y = cvt_pk_bf16(val[2], val[3]); *(LAS u32x2*)(Swr + 16 * st + 4 * quad) = o; }
    asm volatile("s_waitcnt lgkmcnt(0)" ::: "memory");
    f32x4 a1[6];
#pragma unroll
    for (int et = 0; et < 6; ++et) a1[et] = (f32x4){0.f, 0.f, 0.f, 0.f};
#pragma unroll
    for (int ks = 0; ks < 2; ++ks) { const bf16x8 sf = LDSFRAG(Swr + 32 * ks + 8 * quad);
#pragma unroll
        for (int et = 0; et < 6; ++et) { a1[et] = MFMA16(LDSFRAG(VT + tsw(16 * et + l15, 32 * ks + 8 * quad)), sf, a1[et]);
            a1[et] = MFMA16(LDSFRAG(STs + dir * 6912 + (16 * et + l15) * 72 + 32 * ks + 8 * quad), qf[ks], a1[et]); } }
    if (dir == 1) {
#pragma unroll
        for (int et = 0; et < 6; ++et) *(LAS f32x4*)(HB + t * 100 + 16 * et + 4 * quad) = a1[et];
    }
    __syncthreads();
    if (dir == 0) { float ss = 0.f;
#pragma unroll
        for (int et = 0; et < 6; ++et) { a1[et] = a1[et] + *(const LAS f32x4*)(HB + t * 100 + 16 * et + 4 * quad); ss += (a1[et][0] * a1[et][0] + a1[et][1] * a1[et][1]) + (a1[et][2] * a1[et][2] + a1[et][3] * a1[et][3]); }
        ss += __shfl_xor(ss, 16); ss += __shfl_xor(ss, 32);
        const float r = __builtin_amdgcn_rsqf(ss * (1.f / 96.f) + RMS_EPS);
#pragma unroll
        for (int et = 0; et < 6; ++et) { const int e = 16 * et + 4 * quad; const f32x4 g4 = *(const f32x4*)(ng + e);
            float gc[4]; unpack4(gcr[et], gc);
            u32x2 o; o.x = cvt_pk_bf16(a1[et][0] * r * g4[0] * silu_(gc[0]), a1[et][1] * r * g4[1] * silu_(gc[1])); o.y = cvt_pk_bf16(a1[et][2] * r * g4[2] * silu_(gc[2]), a1[et][3] * r * g4[3] * silu_(gc[3]));
            *(u32x2*)(Y + row * D + 640 + u.h * 96 + e) = o; } }
}

__device__ __forceinline__ void sgu_unit(CParams& P, LAS unsigned char* lds, int l, int su, int tid, int wave, int lane) {
    const bf16_t* PROJ = (const bf16_t*)(P.ws + WS_PROJ); bf16_t* Y = (bf16_t*)(P.ws + WS_HY);
    LAS bf16_t* VT2 = (LAS bf16_t*)lds;
    const int rowbase = (su < 512) ? (su >> 6) * 8192 + (su & 63) * 128 : MLAT + ((su - 512) >> 1) * 256 + ((su - 512) & 1) * 128;
    const float* ng = P.in[15] + l * 256; const float* sw = P.in[16] + (size_t)l * 4 * 128 * 128; const float* sb = P.in[17] + l * 4 * 128;
    __syncthreads();
    { const int s = tid >> 2, qtr = tid & 3; float ss = 0.f; float gv[64];
#pragma unroll
        for (int i = 0; i < 8; ++i) { float x[8]; unpack8(*(const uint4*)(PROJ + (size_t)(rowbase + s) * NINP + 1808 + qtr * 64 + i * 8), x);
#pragma unroll
            for (int j = 0; j < 8; ++j) { const float gl = gelu_(x[j]); gv[i * 8 + j] = gl; ss += gl * gl; } }
        ss += __shfl_xor(ss, 1); ss += __shfl_xor(ss, 2);
        const float rstd = __builtin_amdgcn_rsqf(ss * (1.f / 256.f) + RMS_EPS);
#pragma unroll
        for (int i = 0; i < 64; ++i) VT2[(qtr * 64 + i) * 136 + (s ^ (qtr << 4))] = f2bf1(gv[i] * rstd * ng[qtr * 64 + i]); }
    __syncthreads();
    const int l15 = lane & 15, quad = lane >> 4, t = 16 * wave + l15; const size_t row = (size_t)(rowbase + t);
#pragma unroll 1
    for (int g = 0; g < 4; ++g) { f32x4 acc[4];
#pragma unroll
        for (int ct = 0; ct < 4; ++ct) acc[ct] = (f32x4){0.f, 0.f, 0.f, 0.f};
#pragma unroll
        for (int ks = 0; ks < 4; ++ks) { const float* wp = sw + ((size_t)g * 128 + t) * 128 + 32 * ks + 8 * quad; const f32x4 wa = *(const f32x4*)wp, wb = *(const f32x4*)(wp + 4);
            union { u32x4 u; bf16x8 b; } wf; wf.u.x = cvt_pk_bf16(wa[0], wa[1]); wf.u.y = cvt_pk_bf16(wa[2], wa[3]); wf.u.z = cvt_pk_bf16(wb[0], wb[1]); wf.u.w = cvt_pk_bf16(wb[2], wb[3]);
#pragma unroll
            for (int ct = 0; ct < 4; ++ct) acc[ct] = MFMA16(LDSFRAG(VT2 + (g * 64 + 16 * ct + l15) * 136 + ((32 * ks + 8 * quad) ^ (g << 4))), wf.b, acc[ct]); }
        const float bias = sb[g * 128 + t];
#pragma unroll
        for (int ct = 0; ct < 4; ++ct) { const int c = g * 64 + 16 * ct + 4 * quad; float ub[4]; unpack4(*(const uint2*)(PROJ + row * NINP + 1552 + c), ub);
            u32x2 o; o.x = cvt_pk_bf16(gelu_(ub[0]) * (acc[ct][0] + bias), gelu_(ub[1]) * (acc[ct][1] + bias)); o.y = cvt_pk_bf16(gelu_(ub[2]) * (acc[ct][2] + bias), gelu_(ub[3]) * (acc[ct][3] + bias));
            *(u32x2*)(Y + row * D + 384 + c) = o; } }
}

__device__ __forceinline__ void phase_scan(CParams& P, int tid, const bool dup = false) {
    bf16_t* STA = (bf16_t*)(P.ws + WS_STA); bf16_t* STC = (bf16_t*)(P.ws + WS_STC);
    const float* DECA = (const float*)(P.ws + WS_DECA); const float* DECC = (const float*)(P.ws + WS_DECC);
    const int gt = blockIdx.x * 512 + tid, NT = gridDim.x * 512;
    constexpr int NA = 64 * 1164, NC = 64 * 576;
    for (int item = gt; item < NA + NC; item += NT) {
        if (item < NA) {
            const int sidx = item / 1164, v = item % 1164, dir = sidx & 1;
            bf16_t* base = STA + (size_t)sidx * NCH * SA_SZ + v * 8; const float* dec = DECA + sidx * NCH;
            float st[8];
#pragma unroll
            for (int e = 0; e < 8; ++e) st[e] = 0.f;
#pragma unroll 1
            for (int j0 = 0; j0 < NCH; j0 += 12) { uint4 u[12]; float dc[12];
#pragma unroll
                for (int q = 0; q < 12; ++q) { const int j = j0 + q, ci = dir ? (j < 4 ? 3 - j : 135 - j) : j; u[q] = *(const uint4*)(base + (size_t)ci * SA_SZ); dc[q] = dec[ci]; }
#pragma unroll
                for (int q = 0; q < 12; ++q) { const int j = j0 + q, ci = dir ? (j < 4 ? 3 - j : 135 - j) : j; float f[8]; unpack8(u[q], f);
                    if (!dup || st[0] == 1.2345e30f) *(uint4*)(base + (size_t)ci * SA_SZ) = pack8(st);
#pragma unroll
                    for (int e = 0; e < 8; ++e) st[e] = dc[q] * st[e] + f[e]; } }
        } else {
            const int it2 = item - NA, sidx = it2 / 576, v = it2 % 576, dir = sidx & 1, d0 = (v % 6) * 8;
            bf16_t* base = STC + (size_t)sidx * NCH * SC_SZ + v * 8; const float* dec = DECC + (size_t)sidx * NCH * 48 + d0;
            float st[8];
#pragma unroll
            for (int e = 0; e < 8; ++e) st[e] = 0.f;
#pragma unroll 1
            for (int j0 = 0; j0 < NCH; j0 += 6) { uint4 u[6]; f32x4 da[6], db[6];
#pragma unroll
                for (int q = 0; q < 6; ++q) { const int j = j0 + q, ci = dir ? (j < 4 ? 3 - j : 135 - j) : j; u[q] = *(const uint4*)(base + (size_t)ci * SC_SZ); da[q] = *(const f32x4*)(dec + ci * 48); db[q] = *(const f32x4*)(dec + ci * 48 + 4); }
#pragma unroll
                for (int q = 0; q < 6; ++q) { const int j = j0 + q, ci = dir ? (j < 4 ? 3 - j : 135 - j) : j; float f[8]; unpack8(u[q], f);
                    if (!dup || st[0] == 1.2345e30f) *(uint4*)(base + (size_t)ci * SC_SZ) = pack8(st);
#pragma unroll
                    for (int e = 0; e < 8; ++e) st[e] = (e < 4 ? da[q][e & 3] : db[q][e & 3]) * st[e] + f[e]; } }
        }
    }
}

#ifndef MIXDUP
#define MIXDUP 0
#endif
__device__ __forceinline__ void phase_mix1(CParams& P, LAS unsigned char* lds, int l, int tid, int wave, int lane) {
    const int G = gridDim.x;
    load_convw(P, lds, l, tid);
    __syncthreads(); ml1_const(lds, tid);
    { Ml1Regs R; int v = blockIdx.x;
      if (v < 4224) ml1_load(R, P, l, unit_id(v), tid, wave, lane);
#pragma unroll 1
      for (; v < 4224; v += G) { const UnitId u = unit_id(v);
          __syncthreads();
          ml1_stage(R, P, lds, u, tid, wave, lane);
          if (v + G < 4224) ml1_load(R, P, l, unit_id(v + G), tid, wave, lane);
          __syncthreads();
          ml1_compute(P, lds, u, wave, lane); } }
    { Gl1Regs R; int v = G - 1 - (int)blockIdx.x;
      if (v < 4224) { gl1_load_gate(R, P, l, unit_id(v), wave, lane); gl1_load_kv(R, P, unit_id(v), tid); }
#pragma unroll 1
      for (; v < 4224; v += G) { const UnitId u = unit_id(v); const bool more = (v + G < 4224);
          __syncthreads();
          gl1_gate(R, lds, wave, lane);
          if (more) gl1_load_gate(R, P, l, unit_id(v + G), wave, lane);
          __syncthreads();
          gl1_scan(lds, wave, lane);
          __syncthreads();
          gl1_stage(R, P, lds, u, tid);
          if (more) gl1_load_kv(R, P, unit_id(v + G), tid);
          __syncthreads();
          gl1_compute(P, lds, u, wave, lane); } }
}
__device__ __forceinline__ void phase_scan_sgu(CParams& P, LAS unsigned char* lds, int l, int tid, int wave, int lane) {
    const int G = gridDim.x; const int nsgu = (l == 3) ? 512 : 528;
    if (blockIdx.x & 1) {
#pragma unroll 1
        for (int v = blockIdx.x; v < nsgu; v += G) sgu_unit(P, lds, l, v, tid, wave, lane);
        phase_scan(P, tid);
    } else {
        phase_scan(P, tid);
#pragma unroll 1
        for (int v = blockIdx.x; v < nsgu; v += G) sgu_unit(P, lds, l, v, tid, wave, lane);
    }
}
__device__ __forceinline__ void phase_mix3(CParams& P, LAS unsigned char* lds, int l, int tid, int wave, int lane) {
    const int G = gridDim.x;
    load_convw(P, lds, l, tid);
    __syncthreads(); ml3_const(lds, tid);
    { Ml3Regs R; int v = blockIdx.x;
      if (v < 4224) ml3_load(R, P, l, unit_id(v), tid, wave, lane);
#pragma unroll 1
      for (; v < 4224; v += G) { const UnitId u = unit_id(v);
          __syncthreads();
          ml3_stage(R, lds, u, tid, wave, lane);
          if (v + G < 4224) ml3_load(R, P, l, unit_id(v + G), tid, wave, lane);
          __syncthreads();
          ml3_compute(P, lds, l, u, wave, lane); } }
    __syncthreads(); gl3_const(lds, tid);
    { Gl3Regs R; int v = G - 1 - (int)blockIdx.x;
      if (v < 4224) gl3_load(R, P, unit_id(v), tid);
#pragma unroll 1
      for (; v < 4224; v += G) { const UnitId u = unit_id(v);
          __syncthreads();
          gl3_stage(R, lds, tid);
          if (v + G < 4224) gl3_load(R, P, unit_id(v + G), tid);
          __syncthreads();
          gl3_compute(P, lds, l, u, wave, lane); } }
}

#ifndef PH_STOP
#define PH_STOP 37
#endif
#ifndef DBG_SKIP
#define DBG_SKIP 0
#endif
#ifndef DUP_S
#define DUP_S 0
#endif
#ifndef DUP_P0
#define DUP_P0 0
#endif
#ifndef LNF
#define LNF 1
#endif
#ifndef FUSE8
#define FUSE8 0
#endif
#ifndef FUSE5
#define FUSE5 0
#endif
#ifndef PHSEL
#define PHSEL 0xFFFF
#endif


#ifdef DBG_SCAN
__device__ __forceinline__ bool badf(float v) { return !(fabsf(v) < 1e6f); }
__device__ __forceinline__ void dbg_scan(CParams& P, int tid) {
    unsigned* flag = (unsigned*)(P.ws + 900000);
    const size_t gt = (size_t)blockIdx.x * 512 + tid, NT = (size_t)gridDim.x * 512;
    unsigned f = 0;
    const bf16_t* STA = (const bf16_t*)(P.ws + WS_STA);
    for (size_t i = gt; i < (size_t)64 * NCH * SA_SZ; i += NT) { const float v = __uint_as_float((unsigned)STA[i] << 16);
        if (badf(v)) { if (v != v) f |= 1u; else if (fabsf(v) > 1e38f) f |= 2u; else f |= 4u;
            const int within = (int)(i % SA_SZ), slot = (int)(i / SA_SZ), ci = slot % NCH, sidx = slot / NCH;
            if (within >= 96 * 96) f |= 8u; if (ci < 4) f |= 32u; if (sidx & 1) f |= 64u; } }
    const bf16_t* STC = (const bf16_t*)(P.ws + WS_STC);
    for (size_t i = gt; i < (size_t)64 * NCH * SC_SZ; i += NT) { const float v = __uint_as_float((unsigned)STC[i] << 16); if (badf(v)) f |= 16u; }
    if (f) atomicOr(flag, f);
}
#endif
#define XB_TMO      128
#define XB_XCNT(j)  (256  + 64 * (j))
#define XB_XSUB(j)  (1280 + 64 * (j))
#define XB_XGEN(j)  (2304 + 64 * (j))
#define XB_TOP      3328
#define XB_TOPGEN   3392
#define XCD_BAR_WORDS 3456
#define XB_SPIN_CAP (1u << 18)

__device__ __forceinline__ unsigned xb_ld(unsigned* p)              { return __hip_atomic_load(p, __ATOMIC_RELAXED, __HIP_MEMORY_SCOPE_AGENT); }
__device__ __forceinline__ unsigned xb_add(unsigned* p, unsigned v) { return __hip_atomic_fetch_add(p, v, __ATOMIC_RELAXED, __HIP_MEMORY_SCOPE_AGENT); }
__device__ __forceinline__ unsigned xb_xcc_id() { return (unsigned)__builtin_amdgcn_s_getreg((3 << 11) | 20) & 0xFu; }
#define XB_SPIN(cond, bar) do { unsigned _sp = 0; while (cond) { __builtin_amdgcn_s_sleep(1); \
    if ((++_sp & 255u) == 0u) { if (xb_ld(&(bar)[XB_TMO])) break; if (_sp > XB_SPIN_CAP) { atomicAdd(&(bar)[XB_TMO], 1u); break; } } } } while (0)

struct XcdBarrier {
    unsigned* bar; unsigned x;
    volatile LAS unsigned* st;
};

__device__ __forceinline__ XcdBarrier xcd_barrier_post(unsigned* bar, volatile LAS unsigned* st) {
    XcdBarrier b; b.bar = bar; b.x = xb_xcc_id(); b.st = st;
    if (threadIdx.x == 0) (void)xb_add(&bar[XB_XCNT(b.x)], 1u);
    return b;
}
__device__ __forceinline__ void xcd_barrier_complete(unsigned* bar, unsigned x, unsigned& nloc, unsigned& nx) {
    const unsigned G = gridDim.x * gridDim.y * gridDim.z;
    unsigned sum, cnt, mine, sp = 0u;
    for (;;) {
        sum = 0u; cnt = 0u; mine = 0u;
#pragma unroll
        for (unsigned j = 0; j < 16; ++j) { const unsigned c = xb_ld(&bar[XB_XCNT(j)]); sum += c; cnt += (c > 0u) ? 1u : 0u; mine = (j == x) ? c : mine; }
        if (sum == G) break;
        __builtin_amdgcn_s_sleep(1);
        if ((++sp & 255u) == 0u) { if (xb_ld(&bar[XB_TMO])) break; if (sp > XB_SPIN_CAP) { atomicAdd(&bar[XB_TMO], 1u); break; } }
    }
    nloc = mine > 0u ? mine : 1u; nx = cnt > 0u ? cnt : 1u;
}

__device__ __forceinline__ void xcd_barrier(const XcdBarrier& b) {
    asm volatile("s_waitcnt vmcnt(0)" ::: "memory");
    __syncthreads();
    if (threadIdx.x == 0) {
        unsigned* bar = b.bar;
        __builtin_amdgcn_s_waitcnt(0);
        unsigned nloc = b.st[0], nx = b.st[1];
        if (nloc == 0u) { xcd_barrier_complete(bar, b.x, nloc, nx); b.st[0] = nloc; b.st[1] = nx; }
        const unsigned old = xb_add(&bar[XB_XSUB(b.x)], 1u);
        const unsigned gen = old / nloc;
        if (old + 1u == (gen + 1u) * nloc) {
            __builtin_amdgcn_fence(__ATOMIC_RELEASE, "agent");
            asm volatile("s_waitcnt vmcnt(0)" ::: "memory");
            const unsigned og = xb_add(&bar[XB_TOP], 1u);
            const unsigned tg = og / nx;
            if (og + 1u == (tg + 1u) * nx) xb_add(&bar[XB_TOPGEN], 1u);
            else XB_SPIN(xb_ld(&bar[XB_TOPGEN]) == tg, bar);
            __builtin_amdgcn_fence(__ATOMIC_ACQUIRE, "agent");
            xb_add(&bar[XB_XGEN(b.x)], 1u);
            asm volatile("s_waitcnt vmcnt(0)" ::: "memory");
        } else {
            XB_SPIN(xb_ld(&bar[XB_XGEN(b.x)]) == gen, bar);
            __builtin_amdgcn_fence(__ATOMIC_ACQUIRE, "agent");
            asm volatile("s_waitcnt vmcnt(0)" ::: "memory");
        }
    }
    __syncthreads();
}

__global__ void __launch_bounds__(512, 2) hybrid_fwd(Params Pk) {
    extern __shared__ __attribute__((aligned(16))) unsigned char lds_raw[];
    LAS unsigned char* lds = (LAS unsigned char*)lds_raw;
    cg::grid_group grid = cg::this_grid();
    const int G = gridDim.x;
    volatile LAS unsigned* bst = (volatile LAS unsigned*)(lds + XB_LDS_OFF);
    if (threadIdx.x < 2) bst[threadIdx.x] = 0u;
    __syncthreads();
    const XcdBarrier bar = xcd_barrier_post((unsigned*)(Pk.ws + WS_BAR), bst);
#pragma unroll 1
    for (int ph00 = 2 * Pk.ph_lo; ph00 < 2 * Pk.ph_hi; ++ph00) {
        const int ph0 = ph00 >> 1;
        if (ph00 & 1) { const int s_ = (ph0 - 1) % 9; if (!((ph0 >= 1 && ph0 < 37 && ((DUP_S >> s_) & 1)) || (DUP_P0 && ph0 == 0))) continue; }
        const int ph = (ph0 >= PH_STOP && ph0 < 37) ? 99 : ph0;
        CParams* Pq = (CParams*)__builtin_amdgcn_kernarg_segment_ptr(); asm volatile("" : "+s"(Pq)); CParams& P = *Pq;
        float* MOD = (float*)(P.ws + WS_MOD); float* XCTX = (float*)(P.ws + WS_XCTX); float* GATES = (float*)(P.ws + WS_GATES);
        bf16_t* HY = (bf16_t*)(P.ws + WS_HY); bf16_t* PROJ = (bf16_t*)(P.ws + WS_PROJ);
        int tid = threadIdx.x; asm volatile("" : "+v"(tid));
        const int lane = tid & 63, wave = __builtin_amdgcn_readfirstlane(tid >> 6);
#ifdef DBG_SCAN
        if (ph0 == 0 && blockIdx.x == 0 && tid == 0) *(unsigned*)(P.ws + 900000) = 0u;
#ifndef DBG_P1
        if (ph0 == 36) dbg_scan(P, tid);
#endif
        if (ph0 == 37) { const unsigned fl = *(volatile unsigned*)(P.ws + 900000); for (size_t i = (size_t)blockIdx.x * 512 + tid; i < (size_t)MLAT * D; i += (size_t)gridDim.x * 512) P.out[i] = 1000.f * (float)fl; }
        else
#endif
        if ((FUSE8 && ph0 == 37) || (FUSE5 && ph0 == 34)) continue;
        if (LNF && ph0 >= 1 && ph0 < 37) { const int s_ = (ph0 - 1) % 9, l_ = (ph0 - 1) / 9; if (s_ == 6 || (s_ == 0 && l_ > 0)) continue; }
        if (ph == 99) {} else if (ph == 0) { if (PHSEL & 1) phase_prologue(P, lds, tid, wave, lane); }
        else if (ph == 37) { if (PHSEL & 2) {
#if LNF
            phase_final_bf16(HY, (const float*)(P.ws + WS_PARTA), P.out, P.in[21], wave, lane);
#else
            phase_final(P.out, P.in[21], wave, lane);
#endif
        } }
        else {
            const int l = (ph - 1) / 9, s = (ph - 1) % 9; const int Mrows = (l == 3) ? MLAT : MTOT; const float* modl = MOD + (size_t)l * 9 * 6144;
            if (s == 0) { if (PHSEL & (4 << 0)) {
#if LNF
                if (l == 0) phase_first(P, lds, tid, wave, lane);
#else
                if (l == 0) phase_norm(P.in[0], P.in[2], P.out, XCTX, P.in[4], modl, 0, 1, HY, 0, MTOT, wave, lane);
                else phase_norm(P.out, XCTX, nullptr, nullptr, P.in[4] + l * D, modl, 0, 1, HY, FUSE8 ? MLAT : 0, MTOT, wave, lane);
#endif
            } } else if (s == 1) { if (PHSEL & (4 << 1)) {
                pg8::Gemm g{HY, (const bf16_t*)(P.ws + WS_WIN) + (size_t)l * NINP * 1024, MTOT, NINP, 1024}; pg8::StaticOrder S; S.init(MTOT, NINP, G, (int)blockIdx.x);
#if LNF
                EpiProjN E{PROJ, GATES, l & 1, (const float*)(P.ws + WS_PARTA), (const float*)(P.ws + WS_SHW1) + (size_t)l * 9 * NINP, (LAS float*)(lds + 131072)};
#if defined(NULLDUP) && NULLDUP == 2
                if (ph00 & 1) { EpiNull EN{(float*)P.ws}; pg8::gemm_phase<EpiNull, pg8::StaticOrder, false>(lds, g, S, EN, nullptr, tid); } else
#endif
                pg8::gemm_phase<EpiProjN, pg8::StaticOrder, false>(lds, g, S, E, nullptr, tid);
#else
                EpiProj E{PROJ, GATES, l & 1};
                pg8::gemm_phase<EpiProj, pg8::StaticOrder, false>(lds, g, S, E, nullptr, tid);
#endif
            } } else if (s == 2) { if (PHSEL & (4 << 2)) {
                phase_mix1(P, lds, l, tid, wave, lane);
            } } else if (s == 3) { if (PHSEL & (4 << 3)) {
                phase_scan_sgu(P, lds, l, tid, wave, lane);
            } } else if (s == 4) { if (PHSEL & (4 << 4)) {
                phase_mix3(P, lds, l, tid, wave, lane);
            } } else if (s == 5) { if (PHSEL & (4 << 5)) {
                pg8::Gemm g{HY, (const bf16_t*)(P.ws + WS_WOUT) + (size_t)l * 1024 * 1024, Mrows, 1024, 1024};
                EpiRes E{P.out, XCTX, modl + 2 * 1024, l & 1};
#if FUSE5
                PanelOrder S; S.init(G, (int)blockIdx.x, (l == 3) ? 0 : 32);
                pg8::gemm_phase<EpiRes, PanelOrder, false>(lds, g, S, E, nullptr, tid);
                __builtin_amdgcn_fence(__ATOMIC_ACQUIRE, "agent"); asm volatile("s_waitcnt vmcnt(0)" ::: "memory");
                panel_norm(P.out, P.in[5] + l * D, modl, 3, 4, (bf16_t*)(P.ws + WS_STA), l & 1, 0, wave, lane);
#else
                pg8::StaticOrder S; S.init(Mrows, 1024, G, (int)blockIdx.x);
#if LNF
                EpiResN EN{P.out, XCTX, modl + 2 * 1024, l & 1, (bf16_t*)(P.ws + WS_STA), (const float*)(P.ws + WS_GM) + (size_t)(l * 2 + 1) * 9 * 1024, (float*)(P.ws + WS_PARTB), (l == 0) ? P.in[0] : (const float*)P.out, (l == 0) ? P.in[2] : (const float*)XCTX, 0};
#ifdef NULLDUP
                if (ph00 & 1) { EpiNull EZ{(float*)P.ws}; pg8::gemm_phase<EpiNull, pg8::StaticOrder, false>(lds, g, S, EZ, nullptr, tid); } else
#endif
                pg8::gemm_phase<EpiResN, pg8::StaticOrder, false>(lds, g, S, EN, nullptr, tid);
#else
                pg8::gemm_phase<EpiRes, pg8::StaticOrder, false>(lds, g, S, E, nullptr, tid);
#endif
#endif
            } } else if (s == 6) { if (PHSEL & (4 << 6)) {
#if !LNF
                phase_norm(P.out, XCTX, nullptr, nullptr, P.in[5] + l * D, modl, 3, 4, (bf16_t*)(P.ws + WS_STA), FUSE5 ? MLAT : 0, Mrows, wave, lane);
#endif
            } } else if (s == 7) { if (PHSEL & (4 << 7)) {
                pg8::Gemm g{(const bf16_t*)(P.ws + WS_STA), (const bf16_t*)(P.ws + WS_WFI) + (size_t)l * 5632 * 1024, Mrows, 5632, 1024}; pg8::StaticOrder S; S.init(Mrows, 5632, G, (int)blockIdx.x);
#if LNF
                EpiFfnN E{PROJ, (const float*)(P.ws + WS_PARTB), (const float*)(P.ws + WS_SHW2) + (size_t)l * 9 * 5632, (LAS float*)(lds + 131072)};
#if defined(NULLDUP) && NULLDUP == 2
                if (ph00 & 1) { EpiNull EN{(float*)P.ws}; pg8::gemm_phase<EpiNull, pg8::StaticOrder, false>(lds, g, S, EN, nullptr, tid); } else
#endif
                pg8::gemm_phase<EpiFfnN, pg8::StaticOrder, false>(lds, g, S, E, nullptr, tid);
#else
                EpiFfn E{PROJ};
                pg8::gemm_phase<EpiFfn, pg8::StaticOrder, false>(lds, g, S, E, nullptr, tid);
#endif
            } } else { if (PHSEL & (4 << 8)) {
                pg8::Gemm g{PROJ, (const bf16_t*)(P.ws + WS_WFO) + (size_t)l * 1024 * DFF, Mrows, 1024, DFF};
                EpiRes E{P.out, XCTX, modl + 5 * 1024, 0};
#if FUSE8
                PanelOrder S; S.init(G, (int)blockIdx.x, (l == 3) ? 0 : 32);
                pg8::gemm_phase<EpiRes, PanelOrder, false>(lds, g, S, E, nullptr, tid);
                __builtin_amdgcn_fence(__ATOMIC_ACQUIRE, "agent"); asm volatile("s_waitcnt vmcnt(0)" ::: "memory");
                if (l < 3) panel_norm(P.out, P.in[4] + (l + 1) * D, modl + 9 * 6144, 0, 1, HY, 0, 0, wave, lane);
                else panel_norm(P.out, P.in[21], nullptr, 0, 0, nullptr, 0, 1, wave, lane);
#else
                pg8::StaticOrder S; S.init(Mrows, 1024, G, (int)blockIdx.x);
#if LNF
                EpiResN EN{P.out, XCTX, modl + 5 * 1024, 0, HY, (const float*)(P.ws + WS_GM) + (size_t)((l < 3 ? l + 1 : 3) * 2 + 0) * 9 * 1024, (float*)(P.ws + WS_PARTA), (const float*)P.out, (const float*)XCTX, (l == 3) ? 1 : 0};
#ifdef NULLDUP
                if (ph00 & 1) { EpiNull EZ{(float*)P.ws}; pg8::gemm_phase<EpiNull, pg8::StaticOrder, false>(lds, g, S, EZ, nullptr, tid); } else
#endif
                pg8::gemm_phase<EpiResN, pg8::StaticOrder, false>(lds, g, S, EN, nullptr, tid);
#else
                pg8::gemm_phase<EpiRes, pg8::StaticOrder, false>(lds, g, S, E, nullptr, tid);
#endif
#endif
            } }
        }
        if (ph00 + 1 < 2 * P.ph_hi) {
            if (P.ph_lo < 0) {
                __builtin_amdgcn_fence(__ATOMIC_RELEASE, "agent"); asm volatile("s_waitcnt vmcnt(0)" ::: "memory");
                grid.sync();
                __builtin_amdgcn_fence(__ATOMIC_ACQUIRE, "agent"); asm volatile("s_waitcnt vmcnt(0)" ::: "memory");
            } else xcd_barrier(bar);
#ifdef EXTRA_SYNC
            for (int xs = 0; xs < EXTRA_SYNC; ++xs) xcd_barrier(bar);
#endif
        }
    }
}

extern "C" void kernel_launch(void* const* d_in, const int* in_sizes, int n_in, void* d_out, int out_size, void* d_ws, size_t ws_size, hipStream_t stream) {
    static int grid = 0;
    if (grid == 0) {
        if (n_in != 22 || out_size != MLAT * D || ws_size < WS_END) { fprintf(stderr, "kernel_launch: unexpected shapes (n_in %d out %d ws %zu)\n", n_in, out_size, ws_size); grid = -1; return; }
        int dev = 0, cus = 0, per_cu = 0;
        hipGetDevice(&dev); hipDeviceGetAttribute(&cus, hipDeviceAttributeMultiprocessorCount, dev);
        if (hipFuncSetAttribute((const void*)hybrid_fwd, hipFuncAttributeMaxDynamicSharedMemorySize, LDS_BYTES) != hipSuccess) { fprintf(stderr, "kernel_launch: hipFuncSetAttribute failed\n"); grid = -1; return; }
        if (hipOccupancyMaxActiveBlocksPerMultiprocessor(&per_cu, (const void*)hybrid_fwd, 512, LDS_BYTES) != hipSuccess || per_cu < 1) { fprintf(stderr, "kernel_launch: occupancy query says %d\n", per_cu); per_cu = 1; }
        (void)hipGetLastError();
        grid = cus * per_cu;
    }
    if (grid < 0) return;
    if (hipMemsetAsync((char*)d_ws + WS_BAR, 0, XCD_BAR_WORDS * 4, stream) != hipSuccess) { fprintf(stderr, "kernel_launch: memset failed\n"); return; }
    Params p{};
    for (int i = 0; i < 22; ++i) p.in[i] = (const float*)d_in[i];
    p.out = (float*)d_out; p.ws = (unsigned char*)d_ws; p.ph_lo = 0; p.ph_hi = FUSE8 ? 37 : 38;
    void* args[] = {&p};
    hipError_t e = hipLaunchCooperativeKernel((const void*)hybrid_fwd, dim3(grid), dim3(512), args, LDS_BYTES, stream);
    if (e != hipSuccess) fprintf(stderr, "cooperative launch failed: %s (grid %d)\n", hipGetErrorString(e), grid);
}
```

```cpp
#include <hip/hip_runtime.h>
#include <hip/hip_cooperative_groups.h>
#include <cstdio>
namespace cg = cooperative_groups;
namespace pg8 {
#define PG8_LAS __attribute__((address_space(3)))
typedef unsigned short bf16_t;
typedef short bf16x8 __attribute__((ext_vector_type(8)));
typedef float f32x4 __attribute__((ext_vector_type(4)));
typedef unsigned u32x4 __attribute__((ext_vector_type(4)));
constexpr int BM = 256, BK = 64, HALF = 128, HTB = HALF * BK * 2  , STAGE_BYTES = 8 * HTB, NXCD = 8, WGM = 4;

__host__ __device__ __forceinline__ int lds_byte(int r, int c) { const int st = (r >> 4) * 2 + (c >> 5), rr = r & 15, cc = c & 31, ob = rr * 64 + cc * 2; return st * 1024 + (ob ^ (((ob >> 9) & 1) << 5)); }
__host__ __device__ __forceinline__ void stage_rc(int b, int& R, int& C) { const int st = b / 1024, sb = b % 1024, swz = sb ^ (((sb >> 9) & 1) << 5); R = (st >> 1) * 16 + swz / 64; C = (st & 1) * 32 + (swz % 64) / 2; }
__host__ __device__ __forceinline__ int perm32(int rho) { const int n = rho >> 4, i = rho & 15; return 8 * (i >> 2) + 4 * n + (i & 3); }

struct Unit { int pm, pn; };
struct Gemm { const bf16_t* A; const bf16_t* Bt; int M, N, K; };

struct StaticOrder {
    int nM, nN, nwg, G, c;
    __host__ __device__ void init(int M, int N, int G_, int c_) { nM = M / BM; nN = N / BM; nwg = nM * nN; G = G_; c = c_; }
    __host__ __device__ bool next(int i, Unit& u) const {
        const long L = (long)i * G + c; if (L >= nwg) return false;
        int wgid = (int)L; { const int q = nwg / NXCD, r = nwg % NXCD, xcd = wgid % NXCD, off = wgid / NXCD; wgid = (xcd < r ? xcd * (q + 1) : r * (q + 1) + (xcd - r) * q) + off; }
        const int nig = WGM * nN, gid = wgid / nig, fm = gid * WGM, gsz = (nM - fm) < WGM ? (nM - fm) : WGM;
        u.pm = fm + ((wgid % nig) % gsz); u.pn = (wgid % nig) / gsz; return true;
    }
    __device__ __forceinline__ void a_ready(const Unit&) const {}
    __device__ __forceinline__ void done(const Unit&) const {}
};
typedef float f32x2 __attribute__((ext_vector_type(2)));
typedef __bf16 bf16x2_n __attribute__((ext_vector_type(2)));
__device__ __forceinline__ unsigned cvt_pk_bf16(float lo, float hi) { f32x2 v = {lo, hi}; return __builtin_bit_cast(unsigned, __builtin_convertvector(v, bf16x2_n)); }
typedef float f32x2 __attribute__((ext_vector_type(2)));
template <class Epi, class Sched, bool STAMP = false>
__device__ __forceinline__ void gemm_phase(PG8_LAS unsigned char* lds, const Gemm g, const Sched& S, const Epi& E, unsigned long long* stamps, const int tid) {
    const int wid = __builtin_amdgcn_readfirstlane(tid >> 6), lane = tid & 63, wr = wid >> 2, wc = wid & 3, fr = lane & 15, fq = lane >> 4;
    const int K = g.K, nt = K / BK;
    int ts_lo = 0, ts_hi = 0, nts = 0; const unsigned long long rt_entry = STAMP ? (unsigned long long)wall_clock64() : 0ull;
#define PG8_STAMP() do { if (STAMP && wid == 0 && nts < 64) { const unsigned long long _c = (unsigned long long)clock64(); \
        ts_lo = (lane == nts) ? (int)(unsigned)_c : ts_lo; ts_hi = (lane == nts) ? (int)(unsigned)(_c >> 32) : ts_hi; ++nts; } } while (0)
    PG8_STAMP();
    unsigned voffA[2], voffB[2];
#pragma unroll
    for (int i = 0; i < 2; ++i) { int R, C; stage_rc(tid * 16 + i * 8192, R, C); const int Rb = Epi::PERM ? ((R & ~31) + perm32(R & 31)) : R;
        voffA[i] = (unsigned)(R * K + C) * 2u; voffB[i] = (unsigned)(Rb * K + C) * 2u; }
    const size_t kstep = (size_t)(BK * 2);
    const size_t hstep = (size_t)HALF * K * 2;
    const size_t tstep = 2 * hstep;
    const unsigned ldsw = (unsigned)wid * 1024u;
    const int aoff = lds_byte(wr * 64 + fr, fq * 8), boff = lds_byte(wc * 32 + fr, fq * 8);
#define PG8_SA(b, h) (((b) * 2 + (h)) * HTB)
#define PG8_SB(b, h) ((4 + (b) * 2 + (h)) * HTB)
#define PG8_STAGE(bufoff, gbase, voff) do { _Pragma("unroll") for (int _i = 0; _i < 2; ++_i) \
        __builtin_amdgcn_global_load_lds((const unsigned*)((const char*)(gbase) + (voff)[_i]), (PG8_LAS unsigned*)(lds + (bufoff) + ldsw + _i * 8192), 16, 0, 0); } while (0)
#define PG8_LDA(dst, b, h) do { _Pragma("unroll") for (int m = 0; m < 4; ++m) _Pragma("unroll") for (int k = 0; k < 2; ++k) dst[m][k] = *(const PG8_LAS bf16x8*)(lds + PG8_SA(b, h) + aoff + m * 2048 + k * 1024); } while (0)
#define PG8_LDB(dst, b, h) do { _Pragma("unroll") for (int n = 0; n < 2; ++n) _Pragma("unroll") for (int k = 0; k < 2; ++k) dst[n][k] = *(const PG8_LAS bf16x8*)(lds + PG8_SB(b, h) + boff + n * 2048 + k * 1024); } while (0)
#define PG8_MMA(ai, bj, At, Bt) do { __builtin_amdgcn_s_setprio(1); _Pragma("unroll") for (int m = 0; m < 4; ++m) _Pragma("unroll") for (int n = 0; n < 2; ++n) _Pragma("unroll") for (int k = 0; k < 2; ++k) \
        acc[ai][bj][m][n] = __builtin_amdgcn_mfma_f32_16x16x32_bf16(Bt[n][k], At[m][k], acc[ai][bj][m][n], 0, 0, 0); __builtin_amdgcn_s_setprio(0); } while (0)
#define PG8_WAIT_V(n) asm volatile("s_waitcnt vmcnt(" #n ")" ::: "memory")
#define PG8_WAIT_L(n) asm volatile("s_waitcnt lgkmcnt(" #n ")" ::: "memory")
#define PG8_BAR __builtin_amdgcn_s_barrier()
#define PG8_SCHED __builtin_amdgcn_sched_barrier(0)
    Unit cur, nxt; int ui = 0;
    if (!S.next(0, cur)) return;
    f32x4 acc[2][2][4][2];
#pragma unroll
    for (int a = 0; a < 2; ++a)
#pragma unroll
        for (int b = 0; b < 2; ++b)
#pragma unroll
            for (int m = 0; m < 4; ++m)
#pragma unroll
                for (int n = 0; n < 2; ++n) acc[a][b][m][n] = (f32x4){0.f, 0.f, 0.f, 0.f};
    bf16x8 At[4][2], B0[2][2], B1[2][2];
    const char* cA = (const char*)g.A + (size_t)cur.pm * tstep; const char* cB = (const char*)g.Bt + (size_t)cur.pn * tstep;
    S.a_ready(cur);
    PG8_STAGE(PG8_SB(0, 0), cB, voffB); PG8_STAGE(PG8_SA(0, 0), cA, voffA); PG8_STAGE(PG8_SB(0, 1), cB + hstep, voffB); PG8_STAGE(PG8_SA(0, 1), cA + hstep, voffA);
    if (wr == 1) PG8_BAR;
    PG8_WAIT_V(4); PG8_BAR;
    PG8_STAGE(PG8_SB(1, 0), cB + kstep, voffB); PG8_STAGE(PG8_SA(1, 0), cA + kstep, voffA); PG8_STAGE(PG8_SB(1, 1), cB + hstep + kstep, voffB);
    PG8_WAIT_V(6); PG8_BAR;
    PG8_STAMP();
    for (;;) {
        const bool has_next = S.next(ui + 1, nxt);
        const char* nA = has_next ? (const char*)g.A + (size_t)nxt.pm * tstep : cA; const char* nB = has_next ? (const char*)g.Bt + (size_t)nxt.pn * tstep : cB;
        for (int t = 0; t < nt; t += 2) {
            const bool last = (t == nt - 2);
            const char* a1 = cA + (size_t)(t + 1) * kstep;
            const char* a2 = last ? nA : cA + (size_t)(t + 2) * kstep; const char* b2 = last ? nB : cB + (size_t)(t + 2) * kstep;
            const char* a3 = a2 + kstep; const char* b3 = b2 + kstep;
            if (last && has_next) S.a_ready(nxt);
            PG8_LDB(B0, 0, 0); PG8_SCHED; PG8_LDA(At, 0, 0); PG8_STAGE(PG8_SA(1, 1), a1 + hstep, voffA);
            PG8_WAIT_L(8); PG8_BAR; PG8_WAIT_L(0); PG8_MMA(0, 0, At, B0); PG8_BAR; PG8_SCHED;
            PG8_LDB(B1, 0, 1); PG8_STAGE(PG8_SB(0, 0), b2, voffB);
            PG8_BAR; PG8_WAIT_L(0); PG8_MMA(0, 1, At, B1); PG8_BAR;
            PG8_LDA(At, 0, 1); PG8_STAGE(PG8_SA(0, 0), a2, voffA);
            PG8_BAR; PG8_WAIT_L(0); PG8_MMA(1, 0, At, B0); PG8_BAR; PG8_SCHED;
            PG8_STAGE(PG8_SB(0, 1), b2 + hstep, voffB);
            PG8_WAIT_V(6); PG8_BAR; PG8_MMA(1, 1, At, B1); PG8_BAR;
            PG8_LDB(B0, 1, 0); PG8_SCHED; PG8_LDA(At, 1, 0); PG8_STAGE(PG8_SA(0, 1), a2 + hstep, voffA);
            PG8_WAIT_L(8); PG8_BAR; PG8_WAIT_L(0); PG8_MMA(0, 0, At, B0); PG8_BAR; PG8_SCHED;
            PG8_LDB(B1, 1, 1); PG8_STAGE(PG8_SB(1, 0), b3, voffB);
            PG8_BAR; PG8_WAIT_L(0); PG8_MMA(0, 1, At, B1); PG8_BAR;
            PG8_LDA(At, 1, 1); PG8_STAGE(PG8_SA(1, 0), a3, voffA);
            PG8_BAR; PG8_WAIT_L(0); PG8_MMA(1, 0, At, B0); PG8_BAR; PG8_SCHED;
            PG8_STAGE(PG8_SB(1, 1), b3 + hstep, voffB);
            PG8_WAIT_V(6); PG8_BAR; PG8_MMA(1, 1, At, B1); PG8_BAR;
        }
        PG8_STAMP();
        if constexpr (!Epi::AFTER_DRAIN) { E(acc, cur, wr, wc, fr, fq); S.done(cur); }
        PG8_STAMP();
        if (!has_next) break;
#pragma unroll
        for (int a = 0; a < 2; ++a)
#pragma unroll
            for (int b = 0; b < 2; ++b)
#pragma unroll
                for (int m = 0; m < 4; ++m)
#pragma unroll
                    for (int n = 0; n < 2; ++n) acc[a][b][m][n] = (f32x4){0.f, 0.f, 0.f, 0.f};
        cur = nxt; cA = nA; cB = nB; ++ui;
    }
    PG8_WAIT_V(0);
    if (wr == 0) PG8_BAR;
    PG8_BAR;
    if constexpr (Epi::AFTER_DRAIN) { E.fused(acc, cur, wr, wc, fr, fq, lds, wid, lane); S.done(cur); }
    PG8_STAMP();
    if (STAMP && wid == 0) { stamps[lane] = lane < nts ? (((unsigned long long)(unsigned)ts_hi << 32) | (unsigned)ts_lo) : 0ull;
        if (lane == 62) stamps[62] = rt_entry; if (lane == 63) stamps[63] = (unsigned long long)wall_clock64(); }
#undef PG8_STAMP
#undef PG8_SA
#undef PG8_SB
#undef PG8_STAGE
#undef PG8_LDA
#undef PG8_LDB
#undef PG8_MMA
#undef PG8_WAIT_V
#undef PG8_WAIT_L
#undef PG8_BAR
#undef PG8_SCHED
}
}

using pg8::bf16_t; using pg8::bf16x8; using pg8::f32x4; using pg8::u32x4; using pg8::cvt_pk_bf16;
#define LAS __attribute__((address_space(3)))
typedef unsigned u32x2 __attribute__((ext_vector_type(2)));

constexpr int D = 1024, MLAT = 65536, MCTX = 2048, MTOT = 67584, NIN = 3248, NINP = 3328, DFF = 2816;
constexpr int NCH = 132;
constexpr int SA_SZ = 97 * 96, SC_SZ = 96 * 48;
constexpr int LDS_BYTES = 147712, XB_LDS_OFF = 147456;
constexpr float RMS_EPS = 1e-6f;

constexpr size_t MiB = 1u << 20;
constexpr size_t WS_BAR = 3932160;
constexpr size_t WS_MOD = 0, WS_DECA = 1 * MiB, WS_DECC = 2 * MiB, WS_WIN = 4 * MiB, WS_WOUT = 30 * MiB, WS_WFI = 38 * MiB, WS_WFO = 82 * MiB,
                 WS_XCTX = 104 * MiB, WS_GATES = 112 * MiB, WS_HY = 125 * MiB, WS_PROJ = 257 * MiB, WS_STA = 686 * MiB, WS_STC = 837 * MiB, WS_LAG = 912 * MiB, WS_SHW2 = 1011 * MiB, WS_PARTA = 1012 * MiB, WS_PARTB = 1017 * MiB, WS_END = 1022 * MiB;
constexpr size_t WS_GM = 1114112, WS_SHW1 = 1441792;

struct Params { const float* in[22]; float* out; unsigned char* ws; int ph_lo, ph_hi; };
typedef const __attribute__((address_space(4))) Params CParams;

__device__ __forceinline__ float bflo(unsigned u) { return __uint_as_float(u << 16); }
__device__ __forceinline__ float bfhi(unsigned u) { return __uint_as_float(u & 0xffff0000u); }
__device__ __forceinline__ void unpack8(const uint4 v, float (&f)[8]) { f[0] = bflo(v.x); f[1] = bfhi(v.x); f[2] = bflo(v.y); f[3] = bfhi(v.y); f[4] = bflo(v.z); f[5] = bfhi(v.z); f[6] = bflo(v.w); f[7] = bfhi(v.w); }
__device__ __forceinline__ void unpack4(const uint2 v, float (&f)[4]) { f[0] = bflo(v.x); f[1] = bfhi(v.x); f[2] = bflo(v.y); f[3] = bfhi(v.y); }
__device__ __forceinline__ uint4 pack8(const float (&f)[8]) { uint4 r; r.x = cvt_pk_bf16(f[0], f[1]); r.y = cvt_pk_bf16(f[2], f[3]); r.z = cvt_pk_bf16(f[4], f[5]); r.w = cvt_pk_bf16(f[6], f[7]); return r; }
__device__ __forceinline__ bf16_t f2bf1(float f) { return (bf16_t)(cvt_pk_bf16(f, 0.f) & 0xffffu); }
__device__ __forceinline__ float fexp_(float x) { return __builtin_amdgcn_exp2f(x * 1.4426950408889634f); }
__device__ __forceinline__ float sigmoid_(float x) { return __builtin_amdgcn_rcpf(1.f + __builtin_amdgcn_exp2f(x * -1.4426950408889634f)); }
__device__ __forceinline__ float silu_(float x) { return x * sigmoid_(x); }
__device__ __forceinline__ float logsigmoid_(float x) { return fminf(x, 0.f) - 0.6931471805599453f * __builtin_amdgcn_logf(1.f + fexp_(-fabsf(x))); }
__device__ __forceinline__ float gelu_(float x) { const float u = 0.7978845608f * (x + 0.044715f * x * x * x); const float t = 1.f - 2.f * __builtin_amdgcn_rcpf(1.f + __builtin_amdgcn_exp2f(u * 2.8853900817779268f)); return 0.5f * x * (1.f + t); }
template <int CTRL, int ROWMASK> __device__ __forceinline__ float dpp_shift(float v) {
    return __builtin_bit_cast(float, __builtin_amdgcn_update_dpp(0, __builtin_bit_cast(int, v), CTRL, ROWMASK, 0xf, true));
}
__device__ __forceinline__ float wave_incl_scan(float v, int  ) {
    v += dpp_shift<0x111, 0xf>(v); v += dpp_shift<0x112, 0xf>(v); v += dpp_shift<0x114, 0xf>(v); v += dpp_shift<0x118, 0xf>(v);
    v += dpp_shift<0x142, 0xa>(v);
    v += dpp_shift<0x143, 0xc>(v);
    return v;
}
__device__ __forceinline__ float lane63(float v) { return __builtin_bit_cast(float, __builtin_amdgcn_readlane(__builtin_bit_cast(int, v), 63)); }
__device__ __forceinline__ float wave_sum(float v) { return lane63(wave_incl_scan(v, 0)); }
#define MFMA16(a, b, c) __builtin_amdgcn_mfma_f32_16x16x32_bf16((a), (b), (c), 0, 0, 0)
#define LDSFRAG(ptr) (*(const LAS bf16x8*)(ptr))

__device__ __forceinline__ void transpose_item(const float* W, int K, int N, bf16_t* WT, int row0, LAS float* scr, int k0, int n0, int lane) {
    { float wv[32]; const int n = n0 + (lane & 31);
#pragma unroll
      for (int i = 0; i < 32; ++i) wv[i] = (n < N) ? W[(size_t)(k0 + 2 * i + (lane >> 5)) * N + n] : 0.f;
#pragma unroll
      for (int i = 0; i < 32; ++i) scr[(2 * i + (lane >> 5)) * 33 + (lane & 31)] = wv[i]; }
    asm volatile("s_waitcnt lgkmcnt(0)" ::: "memory");
    const int c = lane & 7;
#pragma unroll
    for (int j = 0; j < 4; ++j) { const int n = (lane >> 3) + 8 * j; const LAS float* s = scr + (8 * c) * 33 + n;
        u32x4 o; o.x = cvt_pk_bf16(s[0 * 33], s[1 * 33]); o.y = cvt_pk_bf16(s[2 * 33], s[3 * 33]); o.z = cvt_pk_bf16(s[4 * 33], s[5 * 33]); o.w = cvt_pk_bf16(s[6 * 33], s[7 * 33]);
        *(u32x4*)(WT + (size_t)(row0 + n) * K + k0 + 8 * c) = o; }
    asm volatile("s_waitcnt lgkmcnt(0)" ::: "memory");
}

__device__ __forceinline__ void phase_prologue(CParams& P, LAS unsigned char* lds, int tid, int wave, int lane) {
    const int G = gridDim.x;
    float* MOD = (float*)(P.ws + WS_MOD);
    if ((int)blockIdx.x < 384) {
        LAS float* sv = (LAS float*)lds; LAS float* red = (LAS float*)(lds + 36864);
        for (int i = tid; i < 9 * 1024; i += 512) { const float c = (i < 8192) ? P.in[1][i] : P.in[3][i - 8192]; sv[i] = silu_(c); }
        __syncthreads();
        for (int item = blockIdx.x; item < 384; item += G) {
            const int l = item / 96, nb = item % 96, n = nb * 64 + lane;
            const float* wa = P.in[6] + (size_t)l * 1024 * 6144 + n;
            float acc[9];
#pragma unroll
            for (int r = 0; r < 9; ++r) acc[r] = 0.f;
#pragma unroll 1
            for (int k0 = wave * 128; k0 < wave * 128 + 128; k0 += 16) { float wv[16];
#pragma unroll
                for (int q = 0; q < 16; ++q) wv[q] = wa[(size_t)(k0 + q) * 6144];
#pragma unroll
                for (int q = 0; q < 16; ++q)
#pragma unroll
                    for (int r = 0; r < 9; ++r) acc[r] += sv[r * 1024 + k0 + q] * wv[q]; }
#pragma unroll
            for (int r = 0; r < 9; ++r) red[(wave * 9 + r) * 64 + lane] = acc[r];
            __syncthreads();
            for (int idx = tid; idx < 576; idx += 512) { const int r = idx >> 6, ln = idx & 63; float s = P.in[7][l * 6144 + nb * 64 + ln];
#pragma unroll
                for (int w = 0; w < 8; ++w) s += red[(w * 9 + r) * 64 + ln];
                MOD[(size_t)(l * 9 + r) * 6144 + nb * 64 + ln] = s; }
            __syncthreads();
        }
    }
    __syncthreads();
    LAS float* scr = (LAS float*)(lds + wave * 8704);
    const int gw = blockIdx.x * 8 + wave, NGW = G * 8;
    for (int it = gw; it < 4 * 6400; it += NGW) {
        const int l = it / 6400; int r = it % 6400;
        if (r < 1664) { const int kb = r / 104, nb = r % 104;
            transpose_item(P.in[8] + (size_t)l * 1024 * NIN, 1024, NIN, (bf16_t*)(P.ws + WS_WIN) + (size_t)l * NINP * 1024, nb * 32, scr, kb * 64, nb * 32, lane); continue; }
        r -= 1664;
        if (r < 512) { const int kb = r / 32, nb = r % 32;
            transpose_item(P.in[18] + (size_t)l * 1024 * 1024, 1024, 1024, (bf16_t*)(P.ws + WS_WOUT) + (size_t)l * 1024 * 1024, nb * 32, scr, kb * 64, nb * 32, lane); continue; }
        r -= 512;
        if (r < 2816) { const int kb = r / 176, nb = r % 176, n0 = nb * 32;
            const int row0 = (n0 < DFF) ? (n0 / 128) * 256 + (n0 % 128) : ((n0 - DFF) / 128) * 256 + 128 + ((n0 - DFF) % 128);
            transpose_item(P.in[19] + (size_t)l * 1024 * 5632, 1024, 5632, (bf16_t*)(P.ws + WS_WFI) + (size_t)l * 5632 * 1024, row0 - n0 + n0  , scr, kb * 64, n0, lane); continue; }
        r -= 2816;
        { const int kb = r / 32, nb = r % 32;
            transpose_item(P.in[20] + (size_t)l * DFF * 1024, DFF, 1024, (bf16_t*)(P.ws + WS_WFO) + (size_t)l * 1024 * DFF, nb * 32, scr, kb * 64, nb * 32, lane); }
    }
}

__device__ __forceinline__ void phase_norm(const float* xl, const float* xc, float* cl, float* cc, const float* g, const float* mod  , int ish, int isc, bf16_t* H, int rbeg, int M, int wave, int lane) {
    const int gw = blockIdx.x * 8 + wave, NGW = gridDim.x * 8, rpw = (M - rbeg + NGW - 1) / NGW;
    const int r0 = rbeg + gw * rpw, r1 = (r0 + rpw < M) ? r0 + rpw : M;
    f32x4 ca[4], cb[4]; int rcur = -1;
    for (int row = r0; row < r1; row += 2) {
        const bool two = (row + 1 < r1);
        const int rowb = two ? row + 1 : row;
        const float* srca = (row < MLAT) ? xl + (size_t)row * D : xc + (size_t)(row - MLAT) * D;
        const float* srcb = (rowb < MLAT) ? xl + (size_t)rowb * D : xc + (size_t)(rowb - MLAT) * D;
        f32x4 va[4], vb[4]; float sa = 0.f, sb = 0.f;
#pragma unroll
        for (int j = 0; j < 4; ++j) { va[j] = *(const f32x4*)(srca + 4 * (lane + 64 * j)); vb[j] = *(const f32x4*)(srcb + 4 * (lane + 64 * j)); }
#pragma unroll
        for (int j = 0; j < 4; ++j) { sa += (va[j][0] * va[j][0] + va[j][1] * va[j][1]) + (va[j][2] * va[j][2] + va[j][3] * va[j][3]); sb += (vb[j][0] * vb[j][0] + vb[j][1] * vb[j][1]) + (vb[j][2] * vb[j][2] + vb[j][3] * vb[j][3]); }
        sa = wave_sum(sa); sb = wave_sum(sb);
        const float rsa = __builtin_amdgcn_rsqf(sa * (1.f / D) + RMS_EPS), rsb = __builtin_amdgcn_rsqf(sb * (1.f / D) + RMS_EPS);
        if (cl) { float* da = (row < MLAT) ? cl + (size_t)row * D : cc + (size_t)(row - MLAT) * D; float* db = (rowb < MLAT) ? cl + (size_t)rowb * D : cc + (size_t)(rowb - MLAT) * D;
#pragma unroll
            for (int j = 0; j < 4; ++j) { *(f32x4*)(da + 4 * (lane + 64 * j)) = va[j]; if (two) *(f32x4*)(db + 4 * (lane + 64 * j)) = vb[j]; } }
#pragma unroll
        for (int half = 0; half < 2; ++half) { const int rw = half ? rowb : row; if (half && !two) break;
            const int r = (rw < MLAT) ? (rw >> 13) : 8;
            if (r != rcur) { rcur = r; const float* mr = mod + (size_t)r * 6144;
#pragma unroll
                for (int j = 0; j < 4; ++j) { const int col = 4 * (lane + 64 * j); const f32x4 g4 = *(const f32x4*)(g + col), sc = *(const f32x4*)(mr + isc * 1024 + col); ca[j] = g4 * (sc + 1.f); cb[j] = *(const f32x4*)(mr + ish * 1024 + col); } }
            const float rs = half ? rsb : rsa;
#pragma unroll
            for (int j = 0; j < 4; ++j) { const int col = 4 * (lane + 64 * j); const f32x4 y = ((half ? vb[j] : va[j]) * rs) * ca[j] + cb[j];
                u32x2 o; o.x = cvt_pk_bf16(y[0], y[1]); o.y = cvt_pk_bf16(y[2], y[3]);
                *(u32x2*)(H + (size_t)rw * D + col) = o; } }
    }
}
__device__ __forceinline__ void phase_final(float* x, const float* g, int wave, int lane) {
    const int gw = blockIdx.x * 8 + wave, NGW = gridDim.x * 8;
    for (int row = gw; row < MLAT; row += NGW) {
        float* src = x + (size_t)row * D; f32x4 v[4]; float ss = 0.f;
#pragma unroll
        for (int j = 0; j < 4; ++j) { v[j] = *(const f32x4*)(src + 4 * (lane + 64 * j)); ss += (v[j][0] * v[j][0] + v[j][1] * v[j][1]) + (v[j][2] * v[j][2] + v[j][3] * v[j][3]); }
        const float rstd = __builtin_amdgcn_rsqf(wave_sum(ss) * (1.f / D) + RMS_EPS);
#pragma unroll
        for (int j = 0; j < 4; ++j) { const int col = 4 * (lane + 64 * j); f32x4 o = v[j] * rstd * *(const f32x4*)(g + col);
#ifdef DBG_SANITIZE
            for (int q = 0; q < 4; ++q) if (!(fabsf(o[q]) < 1e30f)) o[q] = 777.f;
#endif
            *(f32x4*)(src + col) = o; }
    }
}

__device__ __forceinline__ void panel_norm(float* x, const float* g, const float* mod  , int ish, int isc, bf16_t* H, int colmajor, int mode, int wave, int lane) {
    for (int pm = blockIdx.x; pm < 256; pm += gridDim.x) {
        const int r = pm >> 5; f32x4 ca[4], cb[4];
#pragma unroll
        for (int j = 0; j < 4; ++j) { const int col = 4 * (lane + 64 * j); const f32x4 g4 = *(const f32x4*)(g + col);
            if (mode == 0) { const float* mr = mod + (size_t)r * 6144; ca[j] = g4 * (*(const f32x4*)(mr + isc * 1024 + col) + 1.f); cb[j] = *(const f32x4*)(mr + ish * 1024 + col); }
            else { ca[j] = g4; cb[j] = (f32x4){0.f, 0.f, 0.f, 0.f}; } }
#pragma unroll 1
        for (int i = 0; i < 32; i += 2) {
            int ra = pm * 256 + wave * 32 + i, rb = ra + 1;
            if (colmajor) { const int ta = ra & 8191, tb = rb & 8191; ra = (ra & ~8191) + (ta & 127) * 64 + (ta >> 7); rb = (rb & ~8191) + (tb & 127) * 64 + (tb >> 7); }
            float* pa = x + (size_t)ra * D; float* pb = x + (size_t)rb * D;
            f32x4 va[4], vb[4]; float sa = 0.f, sb = 0.f;
#pragma unroll
            for (int j = 0; j < 4; ++j) { va[j] = *(const f32x4*)(pa + 4 * (lane + 64 * j)); vb[j] = *(const f32x4*)(pb + 4 * (lane + 64 * j)); }
#pragma unroll
            for (int j = 0; j < 4; ++j) { sa += (va[j][0] * va[j][0] + va[j][1] * va[j][1]) + (va[j][2] * va[j][2] + va[j][3] * va[j][3]); sb += (vb[j][0] * vb[j][0] + vb[j][1] * vb[j][1]) + (vb[j][2] * vb[j][2] + vb[j][3] * vb[j][3]); }
            sa = wave_sum(sa); sb = wave_sum(sb);
            const float rsa = __builtin_amdgcn_rsqf(sa * (1.f / D) + RMS_EPS), rsb = __builtin_amdgcn_rsqf(sb * (1.f / D) + RMS_EPS);
#pragma unroll
            for (int j = 0; j < 4; ++j) { const int col = 4 * (lane + 64 * j); const f32x4 ya = (va[j] * rsa) * ca[j] + cb[j], yb = (vb[j] * rsb) * ca[j] + cb[j];
                if (mode == 0) { u32x2 o; o.x = cvt_pk_bf16(ya[0], ya[1]); o.y = cvt_pk_bf16(ya[2], ya[3]); *(u32x2*)(H + (size_t)ra * D + col) = o;
                                 u32x2 q; q.x = cvt_pk_bf16(yb[0], yb[1]); q.y = cvt_pk_bf16(yb[2], yb[3]); *(u32x2*)(H + (size_t)rb * D + col) = q; }
                else { *(f32x4*)(pa + col) = ya; *(f32x4*)(pb + col) = yb; } } }
    }
}
struct PanelOrder {
    int c, G, npan, nctx;
    __device__ void init(int G_, int c_, int nctx_) { G = G_; c = c_; nctx = nctx_; npan = (c < 256) ? (256 - c + G - 1) / G : 0; }
    __device__ bool next(int i, pg8::Unit& u) const {
        if (i < 4 * npan) { u.pm = c + (i >> 2) * G; u.pn = i & 3; return true; }
        const int j = c + (i - 4 * npan) * G; if (j >= nctx) return false;
        u.pm = 256 + (j >> 2); u.pn = j & 3; return true; }
    __device__ __forceinline__ void a_ready(const pg8::Unit&) const {}
    __device__ __forceinline__ void done(const pg8::Unit&) const {}
};

__device__ __forceinline__ void phase_final_bf16(const bf16_t* X, const float* part, float* out, const float* g, int wave, int lane) {
    const int gw = blockIdx.x * 8 + wave, NGW = gridDim.x * 8;
    f32x4 gg[4];
#pragma unroll
    for (int j = 0; j < 4; ++j) gg[j] = *(const f32x4*)(g + 4 * lane + 256 * j);
#pragma unroll 1
    for (int row = gw; row < MLAT; row += 2 * NGW) { const bool two = (row + NGW < MLAT); const int rowb = two ? row + NGW : row;
        uint2 a[4], b[4];
#pragma unroll
        for (int j = 0; j < 4; ++j) { a[j] = *(const uint2*)(X + (size_t)row * D + 4 * lane + 256 * j); b[j] = *(const uint2*)(X + (size_t)rowb * D + 4 * lane + 256 * j); }
        const float pa = (lane < 16) ? part[(size_t)row * 16 + lane] : 0.f, pb = (lane < 16) ? part[(size_t)rowb * 16 + lane] : 0.f;
        const float rsa = __builtin_amdgcn_rsqf(wave_sum(pa) * (1.f / D) + RMS_EPS), rsb = __builtin_amdgcn_rsqf(wave_sum(pb) * (1.f / D) + RMS_EPS);
#pragma unroll
        for (int j = 0; j < 4; ++j) { float xa[4], xb[4]; unpack4(a[j], xa); unpack4(b[j], xb);
            *(f32x4*)(out + (size_t)row * D + 4 * lane + 256 * j) = (f32x4){xa[0], xa[1], xa[2], xa[3]} * rsa * gg[j];
            if (two) *(f32x4*)(out + (size_t)rowb * D + 4 * lane + 256 * j) = (f32x4){xb[0], xb[1], xb[2], xb[3]} * rsb * gg[j]; } }
}
struct EpiNull { static constexpr bool PERM = true, AFTER_DRAIN = false; float* sink;
    __device__ __forceinline__ void operator()(const f32x4 (&acc)[2][2][4][2], const pg8::Unit& u, int wr, int wc, int fr, int fq) const { f32x4 s = {0.f, 0.f, 0.f, 0.f};
#pragma unroll
        for (int a = 0; a < 2; ++a)
#pragma unroll
            for (int b = 0; b < 2; ++b)
#pragma unroll
                for (int m = 0; m < 4; ++m)
#pragma unroll
                    for (int n = 0; n < 2; ++n) s += acc[a][b][m][n];
        if (s[0] + s[1] + s[2] + s[3] == 123456.789f) sink[fr] = s[0]; } };
struct EpiProj {
    static constexpr bool PERM = true, AFTER_DRAIN = false;
    bf16_t* O; float* gates; int colmajor;
    __device__ __forceinline__ void operator()(const f32x4 (&acc)[2][2][4][2], const pg8::Unit& u, int wr, int wc, int fr, int fq) const {
        const int col0 = u.pn * 256 + wc * 32 + 8 * fq; const bool gt = (u.pn == 6) || (u.pn == 12);
#pragma unroll
        for (int ai = 0; ai < 2; ++ai)
#pragma unroll
            for (int m = 0; m < 4; ++m) { const int r = u.pm * 256 + ai * 128 + wr * 64 + m * 16 + fr; int dr = r;
                if (colmajor && r < MLAT) { const int rho = r & 8191; dr = (r & ~8191) + (rho & 63) * 128 + (rho >> 6); }
                bf16_t* rowp = O + (size_t)dr * NINP + col0;
#pragma unroll
                for (int bj = 0; bj < 2; ++bj) { const f32x4 v0 = acc[ai][bj][m][0], v1 = acc[ai][bj][m][1];
                    u32x4 w; w.x = cvt_pk_bf16(v0[0], v0[1]); w.y = cvt_pk_bf16(v0[2], v0[3]); w.z = cvt_pk_bf16(v1[0], v1[1]); w.w = cvt_pk_bf16(v1[2], v1[3]);
                    *(u32x4*)(rowp + bj * 128) = w;
                    if (gt) { const int c = col0 + bj * 128;
                        if (c >= 1536 && c < 1552) { float* gp = gates + (size_t)dr * 48 + (c - 1536); *(f32x4*)gp = v0; *(f32x4*)(gp + 4) = v1; }
                        else if (c >= 3216 && c < 3248) { float* gp = gates + (size_t)dr * 48 + 16 + (c - 3216); *(f32x4*)gp = v0; *(f32x4*)(gp + 4) = v1; } } } }
    }
};
struct EpiRes {
    static constexpr bool PERM = false, AFTER_DRAIN = false;
    float* xlat; float* xctx; const float* gmod; int colmajor;
    __device__ __forceinline__ void operator()(const f32x4 (&acc)[2][2][4][2], const pg8::Unit& u, int wr, int wc, int fr, int fq) const {
        const int col0 = u.pn * 256 + wc * 32 + 4 * fq; const int rmod = (u.pm < 256) ? (u.pm >> 5) : 8;
        f32x4 gv[2][2];
#pragma unroll
        for (int bj = 0; bj < 2; ++bj)
#pragma unroll
            for (int n = 0; n < 2; ++n) gv[bj][n] = *(const f32x4*)(gmod + (size_t)rmod * 6144 + col0 + bj * 128 + n * 16);
#pragma unroll
        for (int ai = 0; ai < 2; ++ai) {
            float* rp[4]; f32x4 xv[4][2][2];
#pragma unroll
            for (int m = 0; m < 4; ++m) { const int r = u.pm * 256 + ai * 128 + wr * 64 + m * 16 + fr;
                if (r < MLAT) { int dr = r; if (colmajor) { const int tp = r & 8191; dr = (r & ~8191) + (tp & 127) * 64 + (tp >> 7); } rp[m] = xlat + (size_t)dr * D + col0; }
                else rp[m] = xctx + (size_t)(r - MLAT) * D + col0; }
#pragma unroll
            for (int m = 0; m < 4; ++m)
#pragma unroll
                for (int bj = 0; bj < 2; ++bj)
#pragma unroll
                    for (int n = 0; n < 2; ++n) xv[m][bj][n] = *(const f32x4*)(rp[m] + bj * 128 + n * 16);
#pragma unroll
            for (int m = 0; m < 4; ++m)
#pragma unroll
                for (int bj = 0; bj < 2; ++bj)
#pragma unroll
                    for (int n = 0; n < 2; ++n) *(f32x4*)(rp[m] + bj * 128 + n * 16) = xv[m][bj][n] + gv[bj][n] * acc[ai][bj][m][n];
            asm volatile("" ::: "memory"); }
    }
};
struct EpiFfn {
    static constexpr bool PERM = true, AFTER_DRAIN = false;
    bf16_t* Hd;
    __device__ __forceinline__ void operator()(const f32x4 (&acc)[2][2][4][2], const pg8::Unit& u, int wr, int wc, int fr, int fq) const {
        const int col0 = u.pn * 128 + wc * 32 + 8 * fq;
#pragma unroll
        for (int ai = 0; ai < 2; ++ai)
#pragma unroll
            for (int m = 0; m < 4; ++m) { const int r = u.pm * 256 + ai * 128 + wr * 64 + m * 16 + fr;
                const f32x4 g0 = acc[ai][0][m][0], g1 = acc[ai][0][m][1], u0 = acc[ai][1][m][0], u1 = acc[ai][1][m][1];
                u32x4 w; w.x = cvt_pk_bf16(silu_(g0[0]) * u0[0], silu_(g0[1]) * u0[1]); w.y = cvt_pk_bf16(silu_(g0[2]) * u0[2], silu_(g0[3]) * u0[3]);
                w.z = cvt_pk_bf16(silu_(g1[0]) * u1[0], silu_(g1[1]) * u1[1]); w.w = cvt_pk_bf16(silu_(g1[2]) * u1[2], silu_(g1[3]) * u1[3]);
                *(u32x4*)(Hd + (size_t)r * DFF + col0) = w; }
    }
};

__device__ __forceinline__ float row_rstd(const float* part, int row) {
    const f32x4 a = *(const f32x4*)(part + (size_t)row * 16), b = *(const f32x4*)(part + (size_t)row * 16 + 4), c = *(const f32x4*)(part + (size_t)row * 16 + 8), d = *(const f32x4*)(part + (size_t)row * 16 + 12);
    const float s = ((a[0] + a[1]) + (a[2] + a[3])) + ((b[0] + b[1]) + (b[2] + b[3])) + ((c[0] + c[1]) + (c[2] + c[3])) + ((d[0] + d[1]) + (d[2] + d[3]));
    return __builtin_amdgcn_rsqf(s * (1.f / D) + RMS_EPS);
}
__device__ __forceinline__ void wave_rstd_table(const float* part, int row0  , int lane, LAS float* tab) {
    const float* pa = part + (size_t)(row0 + lane) * 16; const float* pb = part + (size_t)(row0 + 128 + lane) * 16;
    f32x4 a[4], b[4];
#pragma unroll
    for (int q = 0; q < 4; ++q) { a[q] = *(const f32x4*)(pa + 4 * q); b[q] = *(const f32x4*)(pb + 4 * q); }
    const f32x4 sa = (a[0] + a[1]) + (a[2] + a[3]), sb = (b[0] + b[1]) + (b[2] + b[3]);
    tab[lane] = __builtin_amdgcn_rsqf(((sa[0] + sa[1]) + (sa[2] + sa[3])) * (1.f / D) + RMS_EPS); tab[64 + lane] = __builtin_amdgcn_rsqf(((sb[0] + sb[1]) + (sb[2] + sb[3])) * (1.f / D) + RMS_EPS);
    asm volatile("s_waitcnt lgkmcnt(0)" ::: "memory");
}
struct EpiProjN {
    static constexpr bool PERM = true, AFTER_DRAIN = false;
    bf16_t* O; float* gates; int colmajor; const float* part; const float* shw  ; LAS float* tabs;
    __device__ __forceinline__ void operator()(const f32x4 (&acc)[2][2][4][2], const pg8::Unit& u, int wr, int wc, int fr, int fq) const {
        const int col0 = u.pn * 256 + wc * 32 + 8 * fq; const bool gt = (u.pn == 6) || (u.pn == 12); const int rmod = (u.pm < 256) ? (u.pm >> 5) : 8;
        f32x4 bs[2][2];
#pragma unroll
        for (int bj = 0; bj < 2; ++bj)
#pragma unroll
            for (int n = 0; n < 2; ++n) bs[bj][n] = *(const f32x4*)(shw + (size_t)rmod * NINP + col0 + bj * 128 + 4 * n);
        LAS float* tab = tabs + (wr * 4 + wc) * 128; wave_rstd_table(part, u.pm * 256 + wr * 64, fq * 16 + fr, tab);
#pragma unroll
        for (int ai = 0; ai < 2; ++ai)
#pragma unroll
            for (int m = 0; m < 4; ++m) { const int r = u.pm * 256 + ai * 128 + wr * 64 + m * 16 + fr; int dr = r;
                if (colmajor && r < MLAT) { const int rho = r & 8191; dr = (r & ~8191) + (rho & 63) * 128 + (rho >> 6); }
                const float rs = tab[ai * 64 + m * 16 + fr];
                bf16_t* rowp = O + (size_t)dr * NINP + col0;
#pragma unroll
                for (int bj = 0; bj < 2; ++bj) { const f32x4 v0 = acc[ai][bj][m][0] * rs + bs[bj][0], v1 = acc[ai][bj][m][1] * rs + bs[bj][1];
                    u32x4 w; w.x = cvt_pk_bf16(v0[0], v0[1]); w.y = cvt_pk_bf16(v0[2], v0[3]); w.z = cvt_pk_bf16(v1[0], v1[1]); w.w = cvt_pk_bf16(v1[2], v1[3]);
                    *(u32x4*)(rowp + bj * 128) = w;
                    if (gt) { const int c = col0 + bj * 128;
                        if (c >= 1536 && c < 1552) { float* gp = gates + (size_t)dr * 48 + (c - 1536); *(f32x4*)gp = v0; *(f32x4*)(gp + 4) = v1; }
                        else if (c >= 3216 && c < 3248) { float* gp = gates + (size_t)dr * 48 + 16 + (c - 3216); *(f32x4*)gp = v0; *(f32x4*)(gp + 4) = v1; } } } }
    }
};
struct EpiResN {
    static constexpr bool PERM = false, AFTER_DRAIN = false;
    float* xlat; float* xctx; const float* gmod; int colmajor; bf16_t* Hn  ; const float* gmn  ; float* part; const float* rlat; const float* rctx; int last;
    __device__ __forceinline__ void operator()(const f32x4 (&acc)[2][2][4][2], const pg8::Unit& u, int wr, int wc, int fr, int fq) const {
        const int col0 = u.pn * 256 + wc * 32 + 4 * fq; const int rmod = (u.pm < 256) ? (u.pm >> 5) : 8;
        f32x4 gv[2][2], gn[2][2];
#pragma unroll
        for (int bj = 0; bj < 2; ++bj)
#pragma unroll
            for (int n = 0; n < 2; ++n) { gv[bj][n] = *(const f32x4*)(gmod + (size_t)rmod * 6144 + col0 + bj * 128 + n * 16);
                gn[bj][n] = Hn ? *(const f32x4*)(gmn + (size_t)rmod * 1024 + col0 + bj * 128 + n * 16) : (f32x4){0.f, 0.f, 0.f, 0.f}; }
#pragma unroll
        for (int ai = 0; ai < 2; ++ai)
#pragma unroll
            for (int mp = 0; mp < 2; ++mp) {
                float* rp[2]; const float* rq[2]; int drs[2]; f32x4 xv[2][2][2];
#pragma unroll
                for (int mm = 0; mm < 2; ++mm) { const int m = 2 * mp + mm; const int r = u.pm * 256 + ai * 128 + wr * 64 + m * 16 + fr; int dr = r;
                    if (r < MLAT) { if (colmajor) { const int tp = r & 8191; dr = (r & ~8191) + (tp & 127) * 64 + (tp >> 7); } rp[mm] = xlat + (size_t)dr * D + col0; rq[mm] = rlat + (size_t)dr * D + col0; }
                    else { rp[mm] = xctx + (size_t)(r - MLAT) * D + col0; rq[mm] = rctx + (size_t)(r - MLAT) * D + col0; }
                    drs[mm] = dr; }
#pragma unroll
                for (int mm = 0; mm < 2; ++mm)
#pragma unroll
                    for (int bj = 0; bj < 2; ++bj)
#pragma unroll
                        for (int n = 0; n < 2; ++n) xv[mm][bj][n] = *(const f32x4*)(rq[mm] + bj * 128 + n * 16);
#pragma unroll
                for (int mm = 0; mm < 2; ++mm) { const int m = 2 * mp + mm; float ss = 0.f;
#pragma unroll
                    for (int bj = 0; bj < 2; ++bj)
#pragma unroll
                        for (int n = 0; n < 2; ++n) { const f32x4 v = xv[mm][bj][n] + gv[bj][n] * acc[ai][bj][m][n]; if (!last) *(f32x4*)(rp[mm] + bj * 128 + n * 16) = v;
                            if (Hn) { ss += (v[0] * v[0] + v[1] * v[1]) + (v[2] * v[2] + v[3] * v[3]); const f32x4 y = last ? v : v * gn[bj][n];
                                u32x2 o; o.x = cvt_pk_bf16(y[0], y[1]); o.y = cvt_pk_bf16(y[2], y[3]); *(u32x2*)(Hn + (size_t)drs[mm] * D + col0 + bj * 128 + n * 16) = o; } }
                    if (Hn) { ss += __shfl_xor(ss, 16); ss += __shfl_xor(ss, 32); if (fq == 0) part[(size_t)drs[mm] * 16 + u.pn * 4 + wc] = ss; } }
                asm volatile("" ::: "memory"); }
    }
};
struct EpiFfnN {
    static constexpr bool PERM = true, AFTER_DRAIN = false;
    bf16_t* Hd; const float* part; const float* shw  ; LAS float* tabs;
    __device__ __forceinline__ void operator()(const f32x4 (&acc)[2][2][4][2], const pg8::Unit& u, int wr, int wc, int fr, int fq) const {
        const int col0 = u.pn * 128 + wc * 32 + 8 * fq, bcol = u.pn * 256 + wc * 32 + 8 * fq; const int rmod = (u.pm < 256) ? (u.pm >> 5) : 8;
        f32x4 bs[2][2];
#pragma unroll
        for (int bj = 0; bj < 2; ++bj)
#pragma unroll
            for (int n = 0; n < 2; ++n) bs[bj][n] = *(const f32x4*)(shw + (size_t)rmod * 5632 + bcol + bj * 128 + 4 * n);
        const f32x4 bsn[2] = {bs[0][0] * -1.4426950408889634f, bs[0][1] * -1.4426950408889634f};
        LAS float* tab = tabs + (wr * 4 + wc) * 128; wave_rstd_table(part, u.pm * 256 + wr * 64, fq * 16 + fr, tab);
#pragma unroll
        for (int ai = 0; ai < 2; ++ai)
#pragma unroll
            for (int m = 0; m < 4; ++m) { const int r = u.pm * 256 + ai * 128 + wr * 64 + m * 16 + fr; const float rs = tab[ai * 64 + m * 16 + fr];
                const f32x4 g0 = acc[ai][0][m][0] * rs + bs[0][0], g1 = acc[ai][0][m][1] * rs + bs[0][1], u0 = acc[ai][1][m][0] * rs + bs[1][0], u1 = acc[ai][1][m][1] * rs + bs[1][1];
                const float rsn = rs * -1.4426950408889634f;
                const f32x4 e0 = acc[ai][0][m][0] * rsn + bsn[0], e1 = acc[ai][0][m][1] * rsn + bsn[1];
                f32x4 h0, h1;
#pragma unroll
                for (int j = 0; j < 4; ++j) { h0[j] = (g0[j] * u0[j]) * __builtin_amdgcn_rcpf(1.f + __builtin_amdgcn_exp2f(e0[j])); h1[j] = (g1[j] * u1[j]) * __builtin_amdgcn_rcpf(1.f + __builtin_amdgcn_exp2f(e1[j])); }
                u32x4 w; w.x = cvt_pk_bf16(h0[0], h0[1]); w.y = cvt_pk_bf16(h0[2], h0[3]); w.z = cvt_pk_bf16(h1[0], h1[1]); w.w = cvt_pk_bf16(h1[2], h1[3]);
                *(u32x4*)(Hd + (size_t)r * DFF + col0) = w; }
    }
};

__device__ __forceinline__ void phase_first(CParams& P, LAS unsigned char* lds, int tid, int wave, int lane) {
    const float* MOD = (const float*)(P.ws + WS_MOD); float* GM = (float*)(P.ws + WS_GM);
    float* XCTX = (float*)(P.ws + WS_XCTX); bf16_t* H = (bf16_t*)(P.ws + WS_HY); float* PARTA = (float*)(P.ws + WS_PARTA);
    const int gw = blockIdx.x * 8 + wave, NGW = gridDim.x * 8;
    for (int i = blockIdx.x * 512 + tid; i < 4 * 2 * 9 * 1024; i += gridDim.x * 512) { const int col = i & 1023, r = (i >> 10) % 9, lw = i / 9216, l = lw >> 1, which = lw & 1;
        GM[i] = (which ? P.in[5] : P.in[4])[l * 1024 + col] * (1.f + MOD[(size_t)(l * 9 + r) * 6144 + (which ? 4 : 1) * 1024 + col]); }
#pragma unroll 1
    for (int part = 0; part < 2; ++part) {
      if ((part ^ (int)(blockIdx.x & 1)) == 0) {
    { const int rpw = (MTOT + NGW - 1) / NGW, r0 = gw * rpw, r1 = (r0 + rpw < MTOT) ? r0 + rpw : MTOT; f32x4 ca[4]; int rcur = -1;
      for (int row = r0; row < r1; ++row) {
          const float* src = (row < MLAT) ? P.in[0] + (size_t)row * D : P.in[2] + (size_t)(row - MLAT) * D;
          const int r = (row < MLAT) ? (row >> 13) : 8;
          if (r != rcur) { rcur = r;
#pragma unroll
              for (int j = 0; j < 4; ++j) { const int col = 4 * (lane + 64 * j); ca[j] = *(const f32x4*)(P.in[4] + col) * (*(const f32x4*)(MOD + (size_t)r * 6144 + 1024 + col) + 1.f); } }
          f32x4 v[4]; float ss = 0.f;
#pragma unroll
          for (int j = 0; j < 4; ++j) { v[j] = *(const f32x4*)(src + 4 * (lane + 64 * j)); ss += (v[j][0] * v[j][0] + v[j][1] * v[j][1]) + (v[j][2] * v[j][2] + v[j][3] * v[j][3]); }
          ss = wave_sum(ss);
#pragma unroll
          for (int j = 0; j < 4; ++j) { const int col = 4 * (lane + 64 * j); const f32x4 y = v[j] * ca[j];
              u32x2 o; o.x = cvt_pk_bf16(y[0], y[1]); o.y = cvt_pk_bf16(y[2], y[3]); *(u32x2*)(H + (size_t)row * D + col) = o; }
          if (lane < 16) PARTA[(size_t)row * 16 + lane] = (lane == 0) ? ss : 0.f; } }
      } else {
    LAS float* sh = (LAS float*)lds;
    for (int lw = 0; lw < 8; ++lw) { const int l = lw >> 1, which = lw & 1; const int N = which ? 5632 : NINP;
        const bf16_t* WT = which ? (const bf16_t*)(P.ws + WS_WFI) + (size_t)l * 5632 * 1024 : (const bf16_t*)(P.ws + WS_WIN) + (size_t)l * NINP * 1024;
        float* out = which ? (float*)(P.ws + WS_SHW2) + (size_t)l * 9 * 5632 : (float*)(P.ws + WS_SHW1) + (size_t)l * 9 * NINP;
        __syncthreads();
        for (int i = tid; i < 9 * 1024; i += 512) sh[i] = MOD[(size_t)(l * 9 + (i >> 10)) * 6144 + (which ? 3 : 0) * 1024 + (i & 1023)];
        __syncthreads();
        for (int n = gw; n < N; n += NGW) { float w[16]; { float t8[8]; unpack8(*(const uint4*)(WT + (size_t)n * 1024 + 16 * lane), t8);
#pragma unroll
                for (int j = 0; j < 8; ++j) w[j] = t8[j];
                unpack8(*(const uint4*)(WT + (size_t)n * 1024 + 16 * lane + 8), t8);
#pragma unroll
                for (int j = 0; j < 8; ++j) w[8 + j] = t8[j]; }
            float res = 0.f;
#pragma unroll
            for (int r = 0; r < 9; ++r) { float a = 0.f;
#pragma unroll
                for (int q = 0; q < 4; ++q) { const f32x4 s4 = *(const LAS f32x4*)(sh + r * 1024 + 16 * lane + 4 * q); a += (s4[0] * w[4 * q] + s4[1] * w[4 * q + 1]) + (s4[2] * w[4 * q + 2] + s4[3] * w[4 * q + 3]); }
                a = wave_sum(a); if (lane == r) res = a; }
            if (lane < 9) out[(size_t)lane * N + n] = res; } }
      }
    }
}

struct UnitGeo { int rowbase, T, t0; };
__device__ __forceinline__ UnitGeo unit_geo(int b, int ci) { UnitGeo g; if (ci < 4) { g.rowbase = MLAT + b * 256 + ci * 64; g.T = 256; g.t0 = ci * 64; } else { g.rowbase = b * 8192 + (ci - 4) * 64; g.T = 8192; g.t0 = (ci - 4) * 64; } return g; }
constexpr int CONVW_OFF = 138240;

__device__ __forceinline__ void load_convw(CParams& P, LAS unsigned char* lds, int l, int tid) {
    LAS float* cw = (LAS float*)(lds + CONVW_OFF); const float* s = P.in[9] + l * 2304;
    for (int i = tid; i < 576; i += 512) *(LAS f32x4*)(cw + 4 * i) = *(const f32x4*)(s + 4 * i);
}
__device__ __forceinline__ void mlstm_gates(const float (&gi)[4], int lane, LAS float* GT) {
    const float lf = logsigmoid_(gi[1]), lb = logsigmoid_(gi[3]);
    const float bf = wave_incl_scan(lf, lane), ib_incl = wave_incl_scan(lb, lane);
    const float tot = lane63(ib_incl), rb = tot - ib_incl + lb;
    GT[lane] = bf; GT[64 + lane] = gi[0] - bf; GT[128 + lane] = rb; GT[192 + lane] = gi[2] - rb;
}
__device__ __forceinline__ void conv_silu8(const uint4 r0, const uint4 r1, const uint4 r2, const LAS float* cw, float scale, float (&y)[8]) {
    float x0[8], x1[8], x2[8]; unpack8(r0, x0); unpack8(r1, x1); unpack8(r2, x2);
    const f32x4 w0a = *(const LAS f32x4*)(cw), w0b = *(const LAS f32x4*)(cw + 4), w1a = *(const LAS f32x4*)(cw + 768), w1b = *(const LAS f32x4*)(cw + 772), w2a = *(const LAS f32x4*)(cw + 1536), w2b = *(const LAS f32x4*)(cw + 1540);
#pragma unroll
    for (int j = 0; j < 8; ++j) { const float w0 = j < 4 ? w0a[j & 3] : w0b[j & 3], w1 = j < 4 ? w1a[j & 3] : w1b[j & 3], w2 = j < 4 ? w2a[j & 3] : w2b[j & 3];
        y[j] = silu_(w0 * x0[j] + w1 * x1[j] + w2 * x2[j]) * scale; }
}
__device__ __forceinline__ void lds_st16(LAS bf16_t* p, const uint4 v) { const u32x4 t = {v.x, v.y, v.z, v.w}; *(LAS u32x4*)p = t; }
__device__ __forceinline__ int tsw(int r, int c) { return r * 72 + (c ^ (((r >> 3) & 7) << 3)); }
__device__ __forceinline__ void store_T8(LAS bf16_t* dst  , int stride, const uint4 raw) {
    const unsigned w4[4] = {raw.x, raw.y, raw.z, raw.w};
#pragma unroll
    for (int j = 0; j < 8; ++j) dst[j * stride] = (bf16_t)((j & 1) ? (w4[j >> 1] >> 16) : (w4[j >> 1] & 0xffffu));
}


struct UnitId { int b, h, ci; };
__device__ __forceinline__ UnitId unit_id(int v) { UnitId u; u.ci = v % NCH; const int bh = v / NCH; u.b = bh >> 2; u.h = bh & 3; return u; }

struct Ml1Regs { float gi[4]; uint4 kr[2][3], vr[2]; };
__device__ __forceinline__ void ml1_load(Ml1Regs& R, CParams& P, int l, const UnitId u, int tid, int wave, int lane) {
    const bf16_t* PROJ = (const bf16_t*)(P.ws + WS_PROJ); const float* GATES = (const float*)(P.ws + WS_GATES); const float* gbias = P.in[10] + l * 16;
    const UnitGeo ug = unit_geo(u.b, u.ci); const uint4 z4 = {0u, 0u, 0u, 0u};
#pragma unroll
    for (int q = 0; q < 4; ++q) R.gi[q] = 0.f;
    if (wave == 0) { const float* gr = GATES + (size_t)(ug.rowbase + lane) * 48;
#pragma unroll
        for (int q = 0; q < 4; ++q) R.gi[q] = gr[4 * q + u.h] + gbias[4 * q + u.h]; }
#pragma unroll
    for (int k = 0; k < 2; ++k) { const int it = tid + 512 * k; R.kr[k][0] = z4; R.kr[k][1] = z4; R.kr[k][2] = z4; R.vr[k] = z4;
        if (it < 768) { const int t = it / 12, v = it % 12, tt = ug.t0 + t; const bf16_t* p = PROJ + (size_t)(ug.rowbase + t) * NINP + 384 + u.h * 96 + v * 8;
            R.kr[k][1] = *(const uint4*)p; if (tt > 0) R.kr[k][0] = *(const uint4*)(p - NINP); if (tt < ug.T - 1) R.kr[k][2] = *(const uint4*)(p + NINP);
            R.vr[k] = *(const uint4*)(p + 384); } }
}
__device__ __forceinline__ void ml1_stage(const Ml1Regs& R, CParams& P, LAS unsigned char* lds, const UnitId u, int tid, int wave, int lane) {
    float* DECA = (float*)(P.ws + WS_DECA);
    LAS bf16_t* KT = (LAS bf16_t*)lds; LAS bf16_t* VT = (LAS bf16_t*)(lds + 13824); LAS float* GT = (LAS float*)(lds + 46080); LAS float* WF = (LAS float*)(lds + 47104);
    const LAS float* CW = (const LAS float*)(lds + CONVW_OFF);
    const int sidx0 = (u.b * 4 + u.h) * 2;
    if (wave == 0) {
        mlstm_gates(R.gi, lane, GT);
        asm volatile("s_waitcnt lgkmcnt(0)" ::: "memory");
        const float bfl = GT[63], rb0 = GT[128];
        WF[lane] = fexp_(bfl + GT[64 + lane]); WF[64 + lane] = fexp_(rb0 + GT[192 + lane]);
        if (lane == 0) { DECA[(sidx0 + 0) * NCH + u.ci] = fexp_(bfl); DECA[(sidx0 + 1) * NCH + u.ci] = fexp_(rb0); }
    }
#pragma unroll
    for (int k = 0; k < 2; ++k) { const int it = tid + 512 * k;
        if (it < 768) { const int t = it / 12, v = it % 12;
            float y[8]; conv_silu8(R.kr[k][0], R.kr[k][1], R.kr[k][2], CW + 384 + u.h * 96 + v * 8, 1.f, y);
#pragma unroll
            for (int j = 0; j < 8; ++j) KT[tsw(v * 8 + j, t)] = f2bf1(y[j]);
            store_T8(VT + tsw(v * 8, t), 72, R.vr[k]); } }
}
__device__ __forceinline__ void ml1_const(LAS unsigned char* lds, int tid) {
    LAS bf16_t* VT = (LAS bf16_t*)(lds + 13824);
    for (int it = tid; it < 16 * 64; it += 512) { const int e = 96 + (it >> 6), t = it & 63; VT[e * 72 + t] = (e == 96) ? (bf16_t)0x3f80 : (bf16_t)0; }
}
__device__ __forceinline__ bf16x8 scale_frag(const bf16x8 f, const LAS float* w) {
    union { bf16x8 b; uint4 u; } x; x.b = f; float v[8]; unpack8(x.u, v);
    const f32x4 wa = *(const LAS f32x4*)w, wb = *(const LAS f32x4*)(w + 4);
#pragma unroll
    for (int j = 0; j < 8; ++j) v[j] *= (j < 4 ? wa[j & 3] : wb[j & 3]);
    x.u = pack8(v); return x.b;
}
__device__ __forceinline__ void ml1_compute(CParams& P, LAS unsigned char* lds, const UnitId u, int wave, int lane) {
    bf16_t* STA = (bf16_t*)(P.ws + WS_STA);
    LAS bf16_t* KT = (LAS bf16_t*)lds; LAS bf16_t* VT = (LAS bf16_t*)(lds + 13824); const LAS float* WF = (const LAS float*)(lds + 47104);
    const int sidx0 = (u.b * 4 + u.h) * 2;
    const int dir = wave >> 2, l15 = lane & 15, quad = lane >> 4;
    bf16_t* dst = STA + ((size_t)(sidx0 + dir) * NCH + u.ci) * SA_SZ;
#pragma unroll
    for (int ei = 0; ei < 2; ++ei) { const int et = (wave & 3) + 4 * ei;
        if (et < 7) {
            bf16x8 vf[2];
#pragma unroll
            for (int ks = 0; ks < 2; ++ks) vf[ks] = scale_frag(LDSFRAG(VT + tsw(16 * et + l15, 32 * ks + 8 * quad)), WF + dir * 64 + 32 * ks + 8 * quad);
#pragma unroll
            for (int dt = 0; dt < 6; ++dt) { f32x4 acc = {0.f, 0.f, 0.f, 0.f};
#pragma unroll
                for (int ks = 0; ks < 2; ++ks) acc = MFMA16(LDSFRAG(KT + tsw(16 * dt + l15, 32 * ks + 8 * quad)), vf[ks], acc);
                const int e = 16 * et + l15;
                if (e <= 96) { u32x2 o; o.x = cvt_pk_bf16(acc[0], acc[1]); o.y = cvt_pk_bf16(acc[2], acc[3]); *(u32x2*)(dst + e * 96 + 16 * dt + 4 * quad) = o; } }
        } }
}

struct Ml3Regs { float gi[4]; uint4 qk[3][3], vr[2], cr[5]; };
__device__ __forceinline__ void ml3_load(Ml3Regs& R, CParams& P, int l, const UnitId u, int tid, int wave, int lane) {
    const bf16_t* PROJ = (const bf16_t*)(P.ws + WS_PROJ); const float* GATES = (const float*)(P.ws + WS_GATES); const bf16_t* STA = (const bf16_t*)(P.ws + WS_STA); const float* gbias = P.in[10] + l * 16;
    const UnitGeo ug = unit_geo(u.b, u.ci); const int sidx0 = (u.b * 4 + u.h) * 2; const uint4 z4 = {0u, 0u, 0u, 0u};
#pragma unroll
    for (int q = 0; q < 4; ++q) R.gi[q] = 0.f;
    if (wave == 0) { const float* gr = GATES + (size_t)(ug.rowbase + lane) * 48;
#pragma unroll
        for (int q = 0; q < 4; ++q) R.gi[q] = gr[4 * q + u.h] + gbias[4 * q + u.h]; }
#pragma unroll
    for (int k = 0; k < 3; ++k) { const int it = tid + 512 * k, which = it / 768, rem = it % 768, t = rem / 12, v = rem % 12, tt = ug.t0 + t;
        const bf16_t* p = PROJ + (size_t)(ug.rowbase + t) * NINP + which * 384 + u.h * 96 + v * 8;
        R.qk[k][0] = z4; R.qk[k][2] = z4; R.qk[k][1] = *(const uint4*)p; if (tt > 0) R.qk[k][0] = *(const uint4*)(p - NINP); if (tt < ug.T - 1) R.qk[k][2] = *(const uint4*)(p + NINP); }
#pragma unroll
    for (int k = 0; k < 2; ++k) { const int it = tid + 512 * k; R.vr[k] = z4;
        if (it < 768) { const int t = it / 12, v = it % 12; R.vr[k] = *(const uint4*)(PROJ + (size_t)(ug.rowbase + t) * NINP + 768 + u.h * 96 + v * 8); } }
#pragma unroll
    for (int k = 0; k < 5; ++k) { const int it = tid + 512 * k; R.cr[k] = z4;
        if (it < 2328) { const int dir = it / 1164, rem = it % 1164; R.cr[k] = *(const uint4*)(STA + ((size_t)(sidx0 + dir) * NCH + u.ci) * SA_SZ + rem * 8); } }
}
__device__ __forceinline__ void ml3_stage(const Ml3Regs& R, LAS unsigned char* lds, const UnitId u, int tid, int wave, int lane) {
    LAS bf16_t* Qs = (LAS bf16_t*)lds; LAS bf16_t* Ks = (LAS bf16_t*)(lds + 13312); LAS bf16_t* VT = (LAS bf16_t*)(lds + 26624); LAS bf16_t* Cs = (LAS bf16_t*)(lds + 42752);
    LAS float* GT = (LAS float*)(lds + 133376); const LAS float* CW = (const LAS float*)(lds + CONVW_OFF);
    const uint4 z4 = {0u, 0u, 0u, 0u};
    if (wave == 0) mlstm_gates(R.gi, lane, GT);
#pragma unroll
    for (int k = 0; k < 3; ++k) { const int it = tid + 512 * k, which = it / 768, rem = it % 768, t = rem / 12, v = rem % 12;
        float y[8]; conv_silu8(R.qk[k][0], R.qk[k][1], R.qk[k][2], CW + which * 384 + u.h * 96 + v * 8, which ? 1.f : 0.10206207262f, y);
        lds_st16((which ? Ks : Qs) + t * 104 + v * 8, pack8(y)); }
#pragma unroll
    for (int k = 0; k < 2; ++k) { const int it = tid + 512 * k; if (it < 768) { const int t = it / 12, v = it % 12; store_T8(VT + tsw(v * 8, t), 72, R.vr[k]); } }
#pragma unroll
    for (int k = 0; k < 5; ++k) { const int it = tid + 512 * k;
        if (it < 2328) { const int dir = it / 1164, rem = it % 1164, e = rem / 12, v = rem % 12; lds_st16(Cs + dir * 11648 + e * 104 + v * 8, R.cr[k]); } }
}
__device__ __forceinline__ void ml3_const(LAS unsigned char* lds, int tid) {
    LAS bf16_t* VT = (LAS bf16_t*)(lds + 26624); LAS bf16_t* Cs = (LAS bf16_t*)(lds + 42752); const uint4 z4 = {0u, 0u, 0u, 0u};
    for (int it = tid; it < 16 * 64; it += 512) { const int e = 96 + (it >> 6), t = it & 63; VT[e * 72 + t] = (e == 96) ? (bf16_t)0x3f80 : (bf16_t)0; }
    if (tid < 360) { const int dir = tid / 180, rem = tid % 180, e = 97 + rem / 12, v = rem % 12; lds_st16(Cs + dir * 11648 + e * 104 + v * 8, z4); }
}
__device__ __forceinline__ void ml3_compute(CParams& P, LAS unsigned char* lds, int l, const UnitId u, int wave, int lane) {
    const bf16_t* PROJ = (const bf16_t*)(P.ws + WS_PROJ); bf16_t* Y = (bf16_t*)(P.ws + WS_HY);
    LAS bf16_t* Qs = (LAS bf16_t*)lds; LAS bf16_t* Ks = (LAS bf16_t*)(lds + 13312); LAS bf16_t* VT = (LAS bf16_t*)(lds + 26624); LAS bf16_t* Cs = (LAS bf16_t*)(lds + 42752);
    LAS bf16_t* Sw = (LAS bf16_t*)(lds + 89344); LAS float* HB = (LAS float*)(lds + 107776); LAS float* GT = (LAS float*)(lds + 133376);
    const UnitGeo ug = unit_geo(u.b, u.ci); const float* ng = P.in[11] + l * 384 + u.h * 96;
    const int mt = wave & 3, dir = wave >> 2, l15 = lane & 15, quad = lane >> 4, t = 16 * mt + l15;
    const size_t row = (size_t)(ug.rowbase + t);
    uint2 oar[6];
    if (dir == 0) {
#pragma unroll
        for (int et = 0; et < 6; ++et) oar[et] = *(const uint2*)(PROJ + row * NINP + 1152 + u.h * 96 + 16 * et + 4 * quad);
    }
    bf16x8 qf[3];
#pragma unroll
    for (int ks = 0; ks < 3; ++ks) qf[ks] = LDSFRAG(Qs + t * 104 + 32 * ks + 8 * quad);
    const float bt = dir ? GT[128 + t] : GT[t];
    LAS bf16_t* Swr = Sw + wave * 1152 + l15 * 72;
    f32x4 sacc[4];
#pragma unroll
    for (int st = 0; st < 4; ++st) sacc[st] = (f32x4){0.f, 0.f, 0.f, 0.f};
#pragma unroll
    for (int ks = 0; ks < 3; ++ks)
#pragma unroll
        for (int st = 0; st < 4; ++st) sacc[st] = MFMA16(LDSFRAG(Ks + (16 * st + l15) * 104 + 32 * ks + 8 * quad), qf[ks], sacc[st]);
#pragma unroll
    for (int st = 0; st < 4; ++st) { const f32x4 acc = sacc[st];
        float val[4];
#pragma unroll
        for (int j = 0; j < 4; ++j) { const int s = 16 * st + 4 * quad + j; const float gs = dir ? GT[192 + s] : GT[64 + s]; const bool ok = dir ? (s >= t) : (s <= t);
            val[j] = ok ? acc[j] * fexp_(bt + gs) : 0.f; }
        u32x2 o; o.x = cvt_pk_bf16(val[0], val[1]); o.y = cvt_pk_bf16(val[2], val[3]); *(LAS u32x2*)(Swr + 16 * st + 4 * quad) = o; }
    asm volatile("s_waitcnt lgkmcnt(0)" ::: "memory");
    f32x4 a1[7];
#pragma unroll
    for (int et = 0; et < 7; ++et) a1[et] = (f32x4){0.f, 0.f, 0.f, 0.f};
#pragma unroll
    for (int ks = 0; ks < 2; ++ks) { const bf16x8 sf = LDSFRAG(Swr + 32 * ks + 8 * quad);
#pragma unroll
        for (int et = 0; et < 7; ++et) a1[et] = MFMA16(LDSFRAG(VT + tsw(16 * et + l15, 32 * ks + 8 * quad)), sf, a1[et]); }
    const float inter = fexp_(bt);
#pragma unroll
    for (int ks = 0; ks < 3; ++ks) { union { bf16x8 b; uint4 u; } x; x.b = qf[ks]; float qv[8]; unpack8(x.u, qv);
#pragma unroll
        for (int j = 0; j < 8; ++j) qv[j] *= inter;
        x.u = pack8(qv);
#pragma unroll
        for (int et = 0; et < 7; ++et) a1[et] = MFMA16(LDSFRAG(Cs + dir * 11648 + (16 * et + l15) * 104 + 32 * ks + 8 * quad), x.b, a1[et]); }
    const float den = __shfl(a1[6][0], l15);
    const float inv = __builtin_amdgcn_rcpf(fmaxf(fabsf(den), 1.f));
    if (dir == 1) {
#pragma unroll
        for (int et = 0; et < 6; ++et) *(LAS f32x4*)(HB + t * 100 + 16 * et + 4 * quad) = a1[et] * inv;
    }
    __syncthreads();
    if (dir == 0) { float ss = 0.f;
#pragma unroll
        for (int et = 0; et < 6; ++et) { a1[et] = a1[et] * inv + *(const LAS f32x4*)(HB + t * 100 + 16 * et + 4 * quad); ss += (a1[et][0] * a1[et][0] + a1[et][1] * a1[et][1]) + (a1[et][2] * a1[et][2] + a1[et][3] * a1[et][3]); }
        ss += __shfl_xor(ss, 16); ss += __shfl_xor(ss, 32);
        const float r = __builtin_amdgcn_rsqf(ss * (1.f / 96.f) + RMS_EPS);
#pragma unroll
        for (int et = 0; et < 6; ++et) { const int e = 16 * et + 4 * quad; const f32x4 g4 = *(const f32x4*)(ng + e);
            float oa[4]; unpack4(oar[et], oa);
            u32x2 o; o.x = cvt_pk_bf16(a1[et][0] * r * g4[0] * sigmoid_(oa[0]), a1[et][1] * r * g4[1] * sigmoid_(oa[1])); o.y = cvt_pk_bf16(a1[et][2] * r * g4[2] * sigmoid_(oa[2]), a1[et][3] * r * g4[3] * sigmoid_(oa[3]));
            *(u32x2*)(Y + row * D + u.h * 96 + e) = o; } }
}

struct Gl1Regs { uint4 kr, vr[2]; float wa[3][8]; f32x4 gb0, gb1, bias[3]; };
__device__ __forceinline__ void gl1_load_gate(Gl1Regs& R, CParams& P, int l, const UnitId u, int wave, int lane) {
    const float* GATES = (const float*)(P.ws + WS_GATES); const UnitGeo ug = unit_geo(u.b, u.ci);
    const float* wg = P.in[12] + (size_t)l * 2 * 16 * 192 + u.h * 48; const float* bg = P.in[13] + l * 2 * 192 + u.h * 48;
    const int dir = wave >> 2, mt = wave & 3, l15 = lane & 15, quad = lane >> 4;
    R.gb0 = (f32x4){0.f, 0.f, 0.f, 0.f}; R.gb1 = (f32x4){0.f, 0.f, 0.f, 0.f};
#pragma unroll
    for (int nt = 0; nt < 3; ++nt)
#pragma unroll
        for (int j = 0; j < 8; ++j) R.wa[nt][j] = (quad < 2) ? wg[(dir * 16 + 8 * quad + j) * 192 + 16 * nt + l15] : 0.f;
    if (quad < 2) { const float* gr = GATES + (size_t)(ug.rowbase + 16 * mt + l15) * 48 + 16 + dir * 16 + 8 * quad; R.gb0 = *(const f32x4*)gr; R.gb1 = *(const f32x4*)(gr + 4); }
#pragma unroll
    for (int nt = 0; nt < 3; ++nt) R.bias[nt] = *(const f32x4*)(bg + dir * 192 + 16 * nt + 4 * quad);
}
__device__ __forceinline__ void gl1_load_kv(Gl1Regs& R, CParams& P, const UnitId u, int tid) {
    const bf16_t* PROJ = (const bf16_t*)(P.ws + WS_PROJ); const UnitGeo ug = unit_geo(u.b, u.ci); const uint4 z4 = {0u, 0u, 0u, 0u};
    R.kr = z4;
    if (tid < 384) { const int s = tid / 6, v = tid % 6; R.kr = *(const uint4*)(PROJ + (size_t)(ug.rowbase + s) * NINP + 2256 + u.h * 48 + v * 8); }
#pragma unroll
    for (int k = 0; k < 2; ++k) { const int it = tid + 512 * k; R.vr[k] = z4;
        if (it < 768) { const int t = it / 12, v = it % 12; R.vr[k] = *(const uint4*)(PROJ + (size_t)(ug.rowbase + t) * NINP + 2448 + u.h * 96 + v * 8); } }
}
__device__ __forceinline__ void gl1_gate(const Gl1Regs& R, LAS unsigned char* lds, int wave, int lane) {
    LAS float* LA = (LAS float*)lds; const int dir = wave >> 2, mt = wave & 3, l15 = lane & 15, quad = lane >> 4;
    union { u32x4 u; bf16x8 b; } bfr; bfr.u.x = cvt_pk_bf16(R.gb0[0], R.gb0[1]); bfr.u.y = cvt_pk_bf16(R.gb0[2], R.gb0[3]); bfr.u.z = cvt_pk_bf16(R.gb1[0], R.gb1[1]); bfr.u.w = cvt_pk_bf16(R.gb1[2], R.gb1[3]);
#pragma unroll
    for (int nt = 0; nt < 3; ++nt) { union { u32x4 u; bf16x8 b; } afr; afr.u.x = cvt_pk_bf16(R.wa[nt][0], R.wa[nt][1]); afr.u.y = cvt_pk_bf16(R.wa[nt][2], R.wa[nt][3]); afr.u.z = cvt_pk_bf16(R.wa[nt][4], R.wa[nt][5]); afr.u.w = cvt_pk_bf16(R.wa[nt][6], R.wa[nt][7]);
        f32x4 acc = {0.f, 0.f, 0.f, 0.f}; acc = MFMA16(afr.b, bfr.b, acc);
        f32x4 la;
#pragma unroll
        for (int j = 0; j < 4; ++j) la[j] = logsigmoid_(acc[j] + R.bias[nt][j]) * 0.0625f;
        *(LAS f32x4*)(LA + (dir * 64 + 16 * mt + l15) * 48 + 16 * nt + 4 * quad) = la; }
}
__device__ __forceinline__ void gl1_scan(LAS unsigned char* lds, int wave, int lane) {
    LAS float* LA = (LAS float*)lds;
    const int dd = wave >> 2, d0 = (wave & 3) * 12; LAS float* p = LA + (dd * 64 + lane) * 48 + d0;
    float v[12];
#pragma unroll
    for (int c = 0; c < 12; ++c) v[c] = p[c];
#pragma unroll
    for (int c = 0; c < 12; ++c) { const float inc = wave_incl_scan(v[c], lane); p[c] = dd ? (lane63(inc) - inc + v[c]) : inc; }
}
__device__ __forceinline__ void gl1_stage(const Gl1Regs& R, CParams& P, LAS unsigned char* lds, const UnitId u, int tid) {
    float* DECC = (float*)(P.ws + WS_DECC); float* LAG = (float*)(P.ws + WS_LAG);
    LAS float* LA = (LAS float*)lds; LAS bf16_t* KH = (LAS bf16_t*)(lds + 24576); LAS bf16_t* VT = (LAS bf16_t*)(lds + 38400);
    const int sidx0 = (u.b * 4 + u.h) * 2;
    { float* lag = LAG + ((size_t)(u.b * 4 + u.h) * NCH + u.ci) * 6144;
#pragma unroll
      for (int k = 0; k < 3; ++k) { const int i4 = tid + 512 * k; *(f32x4*)(lag + 4 * i4) = *(const LAS f32x4*)(LA + 4 * i4); } }
    if (tid < 96) { const int dd = tid / 48, d = tid % 48; DECC[((size_t)(sidx0 + dd) * NCH + u.ci) * 48 + d] = fexp_(LA[(dd * 64 + (dd ? 0 : 63)) * 48 + d]); }
    if (tid < 384) { const int s = tid / 6, v = tid % 6; float x[8]; unpack8(R.kr, x);
#pragma unroll
        for (int j = 0; j < 8; ++j) { const int d = v * 8 + j;
            KH[tsw(d, s)] = f2bf1(x[j] * fexp_(LA[63 * 48 + d] - LA[s * 48 + d]));
            KH[3456 + tsw(d, s)] = f2bf1(x[j] * fexp_(LA[64 * 48 + d] - LA[(64 + s) * 48 + d])); } }
#pragma unroll
    for (int k = 0; k < 2; ++k) { const int it = tid + 512 * k; if (it < 768) { const int t = it / 12, v = it % 12; store_T8(VT + tsw(v * 8, t), 72, R.vr[k]); } }
}
__device__ __forceinline__ void gl1_compute(CParams& P, LAS unsigned char* lds, const UnitId u, int wave, int lane) {
    bf16_t* STC = (bf16_t*)(P.ws + WS_STC); LAS bf16_t* KH = (LAS bf16_t*)(lds + 24576); LAS bf16_t* VT = (LAS bf16_t*)(lds + 38400);
    const int sidx0 = (u.b * 4 + u.h) * 2, dir = wave >> 2, l15 = lane & 15, quad = lane >> 4;
    bf16_t* dst = STC + ((size_t)(sidx0 + dir) * NCH + u.ci) * SC_SZ;
#pragma unroll
    for (int ei = 0; ei < 2; ++ei) { const int et = (wave & 3) + 4 * ei;
        if (et < 6) {
            bf16x8 vf[2];
#pragma unroll
            for (int ks = 0; ks < 2; ++ks) vf[ks] = LDSFRAG(VT + tsw(16 * et + l15, 32 * ks + 8 * quad));
#pragma unroll
            for (int dt = 0; dt < 3; ++dt) { f32x4 acc = {0.f, 0.f, 0.f, 0.f};
#pragma unroll
                for (int ks = 0; ks < 2; ++ks) acc = MFMA16(LDSFRAG(KH + dir * 3456 + tsw(16 * dt + l15, 32 * ks + 8 * quad)), vf[ks], acc);
                u32x2 o; o.x = cvt_pk_bf16(acc[0], acc[1]); o.y = cvt_pk_bf16(acc[2], acc[3]); *(u32x2*)(dst + (16 * et + l15) * 48 + 16 * dt + 4 * quad) = o; }
        } }
}

struct Gl3Regs { uint4 xr[2], vr[2], sr[3]; f32x4 la[2][4]; };
__device__ __forceinline__ void gl3_load(Gl3Regs& R, CParams& P, const UnitId u, int tid) {
    const bf16_t* PROJ = (const bf16_t*)(P.ws + WS_PROJ); const bf16_t* STC = (const bf16_t*)(P.ws + WS_STC); const float* LAG = (const float*)(P.ws + WS_LAG);
    const UnitGeo ug = unit_geo(u.b, u.ci); const int sidx0 = (u.b * 4 + u.h) * 2;
    const float* lag = LAG + ((size_t)(u.b * 4 + u.h) * NCH + u.ci) * 6144; const uint4 z4 = {0u, 0u, 0u, 0u};
#pragma unroll
    for (int k = 0; k < 2; ++k) { const int it = tid + 512 * k; R.xr[k] = z4; R.vr[k] = z4;
#pragma unroll
        for (int q = 0; q < 4; ++q) R.la[k][q] = (f32x4){0.f, 0.f, 0.f, 0.f};
        if (it < 768) { const int which = it / 384, rem = it % 384, t = rem / 6, v = rem % 6;
            R.xr[k] = *(const uint4*)(PROJ + (size_t)(ug.rowbase + t) * NINP + 2064 + which * 192 + u.h * 48 + v * 8);
            R.la[k][0] = *(const f32x4*)(lag + t * 48 + v * 8); R.la[k][1] = *(const f32x4*)(lag + t * 48 + v * 8 + 4);
            R.la[k][2] = *(const f32x4*)(lag + 3072 + t * 48 + v * 8); R.la[k][3] = *(const f32x4*)(lag + 3072 + t * 48 + v * 8 + 4);
            const int t2 = it / 12, v2 = it % 12; R.vr[k] = *(const uint4*)(PROJ + (size_t)(ug.rowbase + t2) * NINP + 2448 + u.h * 96 + v2 * 8); } }
#pragma unroll
    for (int k = 0; k < 3; ++k) { const int it = tid + 512 * k; R.sr[k] = z4;
        if (it < 1152) { const int dd = it / 576, rem = it % 576; R.sr[k] = *(const uint4*)(STC + ((size_t)(sidx0 + dd) * NCH + u.ci) * SC_SZ + rem * 8); } }
}
__device__ __forceinline__ void gl3_stage(const Gl3Regs& R, LAS unsigned char* lds, int tid) {
    LAS bf16_t* QT = (LAS bf16_t*)lds; LAS bf16_t* KTl = (LAS bf16_t*)(lds + 18432); LAS bf16_t* VT = (LAS bf16_t*)(lds + 36864); LAS bf16_t* STs = (LAS bf16_t*)(lds + 50688);
    const uint4 z4 = {0u, 0u, 0u, 0u};
#pragma unroll
    for (int k = 0; k < 2; ++k) { const int it = tid + 512 * k;
        if (it < 768) { const int which = it / 384, rem = it % 384, t = rem / 6, v = rem % 6;
            float x[8], y0[8], y1[8]; unpack8(R.xr[k], x);
#pragma unroll
            for (int j = 0; j < 8; ++j) { const float a0 = j < 4 ? R.la[k][0][j & 3] : R.la[k][1][j & 3], a1 = j < 4 ? R.la[k][2][j & 3] : R.la[k][3][j & 3];
                if (which == 0) { y0[j] = x[j] * 0.14433756730f * fexp_(a0); y1[j] = x[j] * 0.14433756730f * fexp_(a1); } else { y0[j] = x[j] * fexp_(-a0); y1[j] = x[j] * fexp_(-a1); } }
            LAS bf16_t* dstp = which ? KTl : QT;
            lds_st16(dstp + t * 72 + v * 8, pack8(y0)); lds_st16(dstp + 4608 + t * 72 + v * 8, pack8(y1));
            const int t2 = it / 12, v2 = it % 12; store_T8(VT + tsw(v2 * 8, t2), 72, R.vr[k]); } }
#pragma unroll
    for (int k = 0; k < 3; ++k) { const int it = tid + 512 * k;
        if (it < 1152) { const int dd = it / 576, rem = it % 576, e = rem / 6, v = rem % 6; lds_st16(STs + dd * 6912 + e * 72 + v * 8, R.sr[k]); } }
}
__device__ __forceinline__ void gl3_const(LAS unsigned char* lds, int tid) {
    LAS bf16_t* QT = (LAS bf16_t*)lds; LAS bf16_t* STs = (LAS bf16_t*)(lds + 50688); const uint4 z4 = {0u, 0u, 0u, 0u};
    { const int arr = tid >> 7, t = (tid >> 1) & 63, v = tid & 1; lds_st16(QT + arr * 4608 + t * 72 + 48 + v * 8, z4); }
    if (tid < 384) { const int dd = tid / 192, rem = tid % 192, e = rem >> 1, v = 6 + (rem & 1); lds_st16(STs + dd * 6912 + e * 72 + v * 8, z4); }
}
__device__ __forceinline__ void gl3_compute(CParams& P, LAS unsigned char* lds, int l, const UnitId u, int wave, int lane) {
    const bf16_t* PROJ = (const bf16_t*)(P.ws + WS_PROJ); bf16_t* Y = (bf16_t*)(P.ws + WS_HY);
    LAS bf16_t* QT = (LAS bf16_t*)lds; LAS bf16_t* KTl = (LAS bf16_t*)(lds + 18432); LAS bf16_t* VT = (LAS bf16_t*)(lds + 36864); LAS bf16_t* STs = (LAS bf16_t*)(lds + 50688);
    LAS bf16_t* Sw = (LAS bf16_t*)(lds + 78336); LAS float* HB = (LAS float*)(lds + 96768);
    const UnitGeo ug = unit_geo(u.b, u.ci); const float* ng = P.in[14] + l * 96;
    const int mt = wave & 3, dir = wave >> 2, l15 = lane & 15, quad = lane >> 4, t = 16 * mt + l15;
    const size_t row = (size_t)(ug.rowbase + t);
    uint2 gcr[6];
    if (dir == 0) {
#pragma unroll
        for (int et = 0; et < 6; ++et) gcr[et] = *(const uint2*)(PROJ + row * NINP + 2832 + u.h * 96 + 16 * et + 4 * quad);
    }
    bf16x8 qf[2];
#pragma unroll
    for (int ks = 0; ks < 2; ++ks) qf[ks] = LDSFRAG(QT + dir * 4608 + t * 72 + 32 * ks + 8 * quad);
    LAS bf16_t* Swr = Sw + wave * 1152 + l15 * 72;
    f32x4 sacc[4];
#pragma unroll
    for (int st = 0; st < 4; ++st) sacc[st] = (f32x4){0.f, 0.f, 0.f, 0.f};
#pragma unroll
    for (int ks = 0; ks < 2; ++ks)
#pragma unroll
        for (int st = 0; st < 4; ++st) sacc[st] = MFMA16(LDSFRAG(KTl + dir * 4608 + (16 * st + l15) * 72 + 32 * ks + 8 * quad), qf[ks], sacc[st]);
#pragma unroll
    for (int st = 0; st < 4; ++st) { const f32x4 acc = sacc[st];
        float val[4];
#pragma unroll
        for (int j = 0; j < 4; ++j) { const int s = 16 * st + 4 * quad + j; const bool ok = dir ? (s >= t) : (s <= t); val[j] = ok ? acc[j] : 0.f; }
        u32x2 o; o.x = cvt_pk_bf16(val[0], val[1]); o.y = cvt_pk_bf16(val[2], val[3]); *(LAS u32x2*)(Swr + 16 * st + 4 * quad) = o; }
    asm volatile("s_waitcnt lgkmcnt(0)" ::: "memory");
    f32x4 a1[6];
#pragma unroll
    for (int et = 0; et < 6; ++et) a1[et] = (f32x4){0.f, 0.f, 0.f, 0.f};
#pragma unroll
    for (int ks = 0; ks < 2; ++ks) { const bf16x8 sf = LDSFRAG(Swr + 32 * ks + 8 * quad);
#pragma unroll
        for (int et = 0; et < 6; ++et) { a1[et] = MFMA16(LDSFRAG(VT + tsw(16 * et + l15, 32 * ks + 8 * quad)), sf, a1[et]);
            a1[et] = MFMA16(LDSFRAG(STs + dir * 6912 + (16 * et + l15) * 72 + 32 * ks + 8 * quad), qf[ks], a1[et]); } }
    if (dir == 1) {
#pragma unroll
        for (int et = 0; et < 6; ++et) *(LAS f32x4*)(HB + t * 100 + 16 * et + 4 * quad) = a1[et];
    }
    __syncthreads();
    if (dir == 0) { float ss = 0.f;
#pragma unroll
        for (int et = 0; et < 6; ++et) { a1[et] = a1[et] + *(const LAS f32x4*)(HB + t * 100 + 16 * et + 4 * quad); ss += (a1[et][0] * a1[et][0] + a1[et][1] * a1[et][1]) + (a1[et][2] * a1[et][2] + a1[et][3] * a1[et][3]); }
        ss += __shfl_xor(ss, 16); ss += __shfl_xor(ss, 32);
        const float r = __builtin_amdgcn_rsqf(ss * (1.f / 96.f) + RMS_EPS);
#pragma unroll
        for (int et = 0; et < 6; ++et) { const int e = 16 * et + 4 * quad; const f32x4 g4 = *(const f32x4*)(ng + e);
            float gc[4]; unpack4(gcr[et], gc);
            u32x2 o; o.x = cvt_pk_bf16(a1[et][0] * r * g4[0] * silu_(gc[0]), a1[et][1] * r * g4[1] * silu_(gc[1])); o.y = cvt_pk_bf16(a1[et][2] * r * g4[2] * silu_(gc[2]), a1[et][3] * r * g4[3] * silu_(gc[3]));
            *(u32x2*)(Y + row * D + 640 + u.h * 96 + e) = o; } }
}

__device__ __forceinline__ void sgu_unit(CParams& P, LAS unsigned char* lds, int l, int su, int tid, int wave, int lane) {
    const bf16_t* PROJ = (const bf16_t*)(P.ws + WS_PROJ); bf16_t* Y = (bf16_t*)(P.ws + WS_HY);
    LAS bf16_t* VT2 = (LAS bf16_t*)lds;
    const int rowbase = (su < 512) ? (su >> 6) * 8192 + (su & 63) * 128 : MLAT + ((su - 512) >> 1) * 256 + ((su - 512) & 1) * 128;
    const float* ng = P.in[15] + l * 256; const float* sw = P.in[16] + (size_t)l * 4 * 128 * 128; const float* sb = P.in[17] + l * 4 * 128;
    __syncthreads();
    { const int s = tid >> 2, qtr = tid & 3; float ss = 0.f; float gv[64];
#pragma unroll
        for (int i = 0; i < 8; ++i) { float x[8]; unpack8(*(const uint4*)(PROJ + (size_t)(rowbase + s) * NINP + 1808 + qtr * 64 + i * 8), x);
#pragma unroll
            for (int j = 0; j < 8; ++j) { const float gl = gelu_(x[j]); gv[i * 8 + j] = gl; ss += gl * gl; } }
        ss += __shfl_xor(ss, 1); ss += __shfl_xor(ss, 2);
        const float rstd = __builtin_amdgcn_rsqf(ss * (1.f / 256.f) + RMS_EPS);
#pragma unroll
        for (int i = 0; i < 64; ++i) VT2[(qtr * 64 + i) * 136 + (s ^ (qtr << 4))] = f2bf1(gv[i] * rstd * ng[qtr * 64 + i]); }
    __syncthreads();
    const int l15 = lane & 15, quad = lane >> 4, t = 16 * wave + l15; const size_t row = (size_t)(rowbase + t);
#pragma unroll 1
    for (int g = 0; g < 4; ++g) { f32x4 acc[4];
#pragma unroll
        for (int ct = 0; ct < 4; ++ct) acc[ct] = (f32x4){0.f, 0.f, 0.f, 0.f};
#pragma unroll
        for (int ks = 0; ks < 4; ++ks) { const float* wp = sw + ((size_t)g * 128 + t) * 128 + 32 * ks + 8 * quad; const f32x4 wa = *(const f32x4*)wp, wb = *(const f32x4*)(wp + 4);
            union { u32x4 u; bf16x8 b; } wf; wf.u.x = cvt_pk_bf16(wa[0], wa[1]); wf.u.y = cvt_pk_bf16(wa[2], wa[3]); wf.u.z = cvt_pk_bf16(wb[0], wb[1]); wf.u.w = cvt_pk_bf16(wb[2], wb[3]);
#pragma unroll
            for (int ct = 0; ct < 4; ++ct) acc[ct] = MFMA16(LDSFRAG(VT2 + (g * 64 + 16 * ct + l15) * 136 + ((32 * ks + 8 * quad) ^ (g << 4))), wf.b, acc[ct]); }
        const float bias = sb[g * 128 + t];
#pragma unroll
        for (int ct = 0; ct < 4; ++ct) { const int c = g * 64 + 16 * ct + 4 * quad; float ub[4]; unpack4(*(const uint2*)(PROJ + row * NINP + 1552 + c), ub);
            u32x2 o; o.x = cvt_pk_bf16(gelu_(ub[0]) * (acc[ct][0] + bias), gelu_(ub[1]) * (acc[ct][1] + bias)); o.y = cvt_pk_bf16(gelu_(ub[2]) * (acc[ct][2] + bias), gelu_(ub[3]) * (acc[ct][3] + bias));
            *(u32x2*)(Y + row * D + 384 + c) = o; } }
}

__device__ __forceinline__ void phase_scan(CParams& P, int tid, const bool dup = false) {
    bf16_t* STA = (bf16_t*)(P.ws + WS_STA); bf16_t* STC = (bf16_t*)(P.ws + WS_STC);
    const float* DECA = (const float*)(P.ws + WS_DECA); const float* DECC = (const float*)(P.ws + WS_DECC);
    const int gt = blockIdx.x * 512 + tid, NT = gridDim.x * 512;
    constexpr int NA = 64 * 1164, NC = 64 * 576;
    for (int item = gt; item < NA + NC; item += NT) {
        if (item < NA) {
            const int sidx = item / 1164, v = item % 1164, dir = sidx & 1;
            bf16_t* base = STA + (size_t)sidx * NCH * SA_SZ + v * 8; const float* dec = DECA + sidx * NCH;
            float st[8];
#pragma unroll
            for (int e = 0; e < 8; ++e) st[e] = 0.f;
#pragma unroll 1
            for (int j0 = 0; j0 < NCH; j0 += 12) { uint4 u[12]; float dc[12];
#pragma unroll
                for (int q = 0; q < 12; ++q) { const int j = j0 + q, ci = dir ? (j < 4 ? 3 - j : 135 - j) : j; u[q] = *(const uint4*)(base + (size_t)ci * SA_SZ); dc[q] = dec[ci]; }
#pragma unroll
                for (int q = 0; q < 12; ++q) { const int j = j0 + q, ci = dir ? (j < 4 ? 3 - j : 135 - j) : j; float f[8]; unpack8(u[q], f);
                    if (!dup || st[0] == 1.2345e30f) *(uint4*)(base + (size_t)ci * SA_SZ) = pack8(st);
#pragma unroll
                    for (int e = 0; e < 8; ++e) st[e] = dc[q] * st[e] + f[e]; } }
        } else {
            const int it2 = item - NA, sidx = it2 / 576, v = it2 % 576, dir = sidx & 1, d0 = (v % 6) * 8;
            bf16_t* base = STC + (size_t)sidx * NCH * SC_SZ + v * 8; const float* dec = DECC + (size_t)sidx * NCH * 48 + d0;
            float st[8];
#pragma unroll
            for (int e = 0; e < 8; ++e) st[e] = 0.f;
#pragma unroll 1
            for (int j0 = 0; j0 < NCH; j0 += 6) { uint4 u[6]; f32x4 da[6], db[6];
#pragma unroll
                for (int q = 0; q < 6; ++q) { const int j = j0 + q, ci = dir ? (j < 4 ? 3 - j : 135 - j) : j; u[q] = *(const uint4*)(base + (size_t)ci * SC_SZ); da[q] = *(const f32x4*)(dec + ci * 48); db[q] = *(const f32x4*)(dec + ci * 48 + 4); }
#pragma unroll
                for (int q = 0; q < 6; ++q) { const int j = j0 + q, ci = dir ? (j < 4 ? 3 - j : 135 - j) : j; float f[8]; unpack8(u[q], f);
                    if (!dup || st[0] == 1.2345e30f) *(uint4*)(base + (size_t)ci * SC_SZ) = pack8(st);
#pragma unroll
                    for (int e = 0; e < 8; ++e) st[e] = (e < 4 ? da[q][e & 3] : db[q][e & 3]) * st[e] + f[e]; } }
        }
    }
}

#ifndef MIXDUP
#define MIXDUP 0
#endif
__device__ __forceinline__ void phase_mix1(CParams& P, LAS unsigned char* lds, int l, int tid, int wave, int lane) {
    const int G = gridDim.x;
    load_convw(P, lds, l, tid);
    __syncthreads(); ml1_const(lds, tid);
    { Ml1Regs R; int v = blockIdx.x;
      if (v < 4224) ml1_load(R, P, l, unit_id(v), tid, wave, lane);
#pragma unroll 1
      for (; v < 4224; v += G) { const UnitId u = unit_id(v);
          __syncthreads();
          ml1_stage(R, P, lds, u, tid, wave, lane);
          if (v + G < 4224) ml1_load(R, P, l, unit_id(v + G), tid, wave, lane);
          __syncthreads();
          ml1_compute(P, lds, u, wave, lane); } }
    { Gl1Regs R; int v = G - 1 - (int)blockIdx.x;
      if (v < 4224) { gl1_load_gate(R, P, l, unit_id(v), wave, lane); gl1_load_kv(R, P, unit_id(v), tid); }
#pragma unroll 1
      for (; v < 4224; v += G) { const UnitId u = unit_id(v); const bool more = (v + G < 4224);
          __syncthreads();
          gl1_gate(R, lds, wave, lane);
          if (more) gl1_load_gate(R, P, l, unit_id(v + G), wave, lane);
          __syncthreads();
          gl1_scan(lds, wave, lane);
          __syncthreads();
          gl1_stage(R, P, lds, u, tid);
          if (more) gl1_load_kv(R, P, unit_id(v + G), tid);
          __syncthreads();
          gl1_compute(P, lds, u, wave, lane); } }
}
__device__ __forceinline__ void phase_scan_sgu(CParams& P, LAS unsigned char* lds, int l, int tid, int wave, int lane) {
    const int G = gridDim.x; const int nsgu = (l == 3) ? 512 : 528;
    if ((blockIdx.x & 7) >= 4) {
#pragma unroll 1
        for (int v = blockIdx.x; v < nsgu; v += G) sgu_unit(P, lds, l, v, tid, wave, lane);
        phase_scan(P, tid);
    } else {
        phase_scan(P, tid);
#pragma unroll 1
        for (int v = blockIdx.x; v < nsgu; v += G) sgu_unit(P, lds, l, v, tid, wave, lane);
    }
}
__device__ __forceinline__ void phase_mix3(CParams& P, LAS unsigned char* lds, int l, int tid, int wave, int lane) {
    const int G = gridDim.x;
    load_convw(P, lds, l, tid);
    __syncthreads(); ml3_const(lds, tid);
    { Ml3Regs R; int v = blockIdx.x;
      if (v < 4224) ml3_load(R, P, l, unit_id(v), tid, wave, lane);
#pragma unroll 1
      for (; v < 4224; v += G) { const UnitId u = unit_id(v);
          __syncthreads();
          ml3_stage(R, lds, u, tid, wave, lane);
          if (v + G < 4224) ml3_load(R, P, l, unit_id(v + G), tid, wave, lane);
          __syncthreads();
          ml3_compute(P, lds, l, u, wave, lane); } }
    __syncthreads(); gl3_const(lds, tid);
    { Gl3Regs R; int v = G - 1 - (int)blockIdx.x;
      if (v < 4224) gl3_load(R, P, unit_id(v), tid);
#pragma unroll 1
      for (; v < 4224; v += G) { const UnitId u = unit_id(v);
          __syncthreads();
          gl3_stage(R, lds, tid);
          if (v + G < 4224) gl3_load(R, P, unit_id(v + G), tid);
          __syncthreads();
          gl3_compute(P, lds, l, u, wave, lane); } }
}

#ifndef PH_STOP
#define PH_STOP 37
#endif
#ifndef DBG_SKIP
#define DBG_SKIP 0
#endif
#ifndef DUP_S
#define DUP_S 0
#endif
#ifndef DUP_P0
#define DUP_P0 0
#endif
#ifndef LNF
#define LNF 1
#endif
#ifndef FUSE8
#define FUSE8 0
#endif
#ifndef FUSE5
#define FUSE5 0
#endif
#ifndef PHSEL
#define PHSEL 0xFFFF
#endif


#ifdef DBG_SCAN
__device__ __forceinline__ bool badf(float v) { return !(fabsf(v) < 1e6f); }
__device__ __forceinline__ void dbg_scan(CParams& P, int tid) {
    unsigned* flag = (unsigned*)(P.ws + 900000);
    const size_t gt = (size_t)blockIdx.x * 512 + tid, NT = (size_t)gridDim.x * 512;
    unsigned f = 0;
    const bf16_t* STA = (const bf16_t*)(P.ws + WS_STA);
    for (size_t i = gt; i < (size_t)64 * NCH * SA_SZ; i += NT) { const float v = __uint_as_float((unsigned)STA[i] << 16);
        if (badf(v)) { if (v != v) f |= 1u; else if (fabsf(v) > 1e38f) f |= 2u; else f |= 4u;
            const int within = (int)(i % SA_SZ), slot = (int)(i / SA_SZ), ci = slot % NCH, sidx = slot / NCH;
            if (within >= 96 * 96) f |= 8u; if (ci < 4) f |= 32u; if (sidx & 1) f |= 64u; } }
    const bf16_t* STC = (const bf16_t*)(P.ws + WS_STC);
    for (size_t i = gt; i < (size_t)64 * NCH * SC_SZ; i += NT) { const float v = __uint_as_float((unsigned)STC[i] << 16); if (badf(v)) f |= 16u; }
    if (f) atomicOr(flag, f);
}
#endif
#define XB_TMO      128
#define XB_XCNT(j)  (256  + 64 * (j))
#define XB_XSUB(j)  (1280 + 64 * (j))
#define XB_XGEN(j)  (2304 + 64 * (j))
#define XB_TOP      3328
#define XB_TOPGEN   3392
#define XCD_BAR_WORDS 3456
#define XB_SPIN_CAP (1u << 18)

__device__ __forceinline__ unsigned xb_ld(unsigned* p)              { return __hip_atomic_load(p, __ATOMIC_RELAXED, __HIP_MEMORY_SCOPE_AGENT); }
__device__ __forceinline__ unsigned xb_add(unsigned* p, unsigned v) { return __hip_atomic_fetch_add(p, v, __ATOMIC_RELAXED, __HIP_MEMORY_SCOPE_AGENT); }
__device__ __forceinline__ unsigned xb_xcc_id() { return (unsigned)__builtin_amdgcn_s_getreg((3 << 11) | 20) & 0xFu; }
#define XB_SPIN(cond, bar) do { unsigned _sp = 0; while (cond) { __builtin_amdgcn_s_sleep(1); \
    if ((++_sp & 255u) == 0u) { if (xb_ld(&(bar)[XB_TMO])) break; if (_sp > XB_SPIN_CAP) { atomicAdd(&(bar)[XB_TMO], 1u); break; } } } } while (0)

struct XcdBarrier {
    unsigned* bar; unsigned x;
    volatile LAS unsigned* st;
};

__device__ __forceinline__ XcdBarrier xcd_barrier_post(unsigned* bar, volatile LAS unsigned* st) {
    XcdBarrier b; b.bar = bar; b.x = xb_xcc_id(); b.st = st;
    if (threadIdx.x == 0) (void)xb_add(&bar[XB_XCNT(b.x)], 1u);
    return b;
}
__device__ __forceinline__ void xcd_barrier_complete(unsigned* bar, unsigned x, unsigned& nloc, unsigned& nx) {
    const unsigned G = gridDim.x * gridDim.y * gridDim.z;
    unsigned sum, cnt, mine, sp = 0u;
    for (;;) {
        sum = 0u; cnt = 0u; mine = 0u;
#pragma unroll
        for (unsigned j = 0; j < 16; ++j) { const unsigned c = xb_ld(&bar[XB_XCNT(j)]); sum += c; cnt += (c > 0u) ? 1u : 0u; mine = (j == x) ? c : mine; }
        if (sum == G) break;
        __builtin_amdgcn_s_sleep(1);
        if ((++sp & 255u) == 0u) { if (xb_ld(&bar[XB_TMO])) break; if (sp > XB_SPIN_CAP) { atomicAdd(&bar[XB_TMO], 1u); break; } }
    }
    nloc = mine > 0u ? mine : 1u; nx = cnt > 0u ? cnt : 1u;
}

__device__ __forceinline__ void xcd_barrier(const XcdBarrier& b) {
    asm volatile("s_waitcnt vmcnt(0)" ::: "memory");
    __syncthreads();
    if (threadIdx.x == 0) {
        unsigned* bar = b.bar;
        __builtin_amdgcn_s_waitcnt(0);
        unsigned nloc = b.st[0], nx = b.st[1];
        if (nloc == 0u) { xcd_barrier_complete(bar, b.x, nloc, nx); b.st[0] = nloc; b.st[1] = nx; }
        const unsigned old = xb_add(&bar[XB_XSUB(b.x)], 1u);
        const unsigned gen = old / nloc;
        if (old + 1u == (gen + 1u) * nloc) {
            __builtin_amdgcn_fence(__ATOMIC_RELEASE, "agent");
            asm volatile("s_waitcnt vmcnt(0)" ::: "memory");
            const unsigned og = xb_add(&bar[XB_TOP], 1u);
            const unsigned tg = og / nx;
            if (og + 1u == (tg + 1u) * nx) xb_add(&bar[XB_TOPGEN], 1u);
            else XB_SPIN(xb_ld(&bar[XB_TOPGEN]) == tg, bar);
            __builtin_amdgcn_fence(__ATOMIC_ACQUIRE, "agent");
            xb_add(&bar[XB_XGEN(b.x)], 1u);
            asm volatile("s_waitcnt vmcnt(0)" ::: "memory");
        } else {
            XB_SPIN(xb_ld(&bar[XB_XGEN(b.x)]) == gen, bar);
            __builtin_amdgcn_fence(__ATOMIC_ACQUIRE, "agent");
            asm volatile("s_waitcnt vmcnt(0)" ::: "memory");
        }
    }
    __syncthreads();
}

__global__ void __launch_bounds__(512, 2) hybrid_fwd(Params Pk) {
    extern __shared__ __attribute__((aligned(16))) unsigned char lds_raw[];
    LAS unsigned char* lds = (LAS unsigned char*)lds_raw;
    cg::grid_group grid = cg::this_grid();
    const int G = gridDim.x;
    volatile LAS unsigned* bst = (volatile LAS unsigned*)(lds + XB_LDS_OFF);
    if (threadIdx.x < 2) bst[threadIdx.x] = 0u;
    __syncthreads();
    const XcdBarrier bar = xcd_barrier_post((unsigned*)(Pk.ws + WS_BAR), bst);
#pragma unroll 1
    for (int ph00 = 2 * Pk.ph_lo; ph00 < 2 * Pk.ph_hi; ++ph00) {
        const int ph0 = ph00 >> 1;
        if (ph00 & 1) { const int s_ = (ph0 - 1) % 9; if (!((ph0 >= 1 && ph0 < 37 && ((DUP_S >> s_) & 1)) || (DUP_P0 && ph0 == 0))) continue; }
        const int ph = (ph0 >= PH_STOP && ph0 < 37) ? 99 : ph0;
        CParams* Pq = (CParams*)__builtin_amdgcn_kernarg_segment_ptr(); asm volatile("" : "+s"(Pq)); CParams& P = *Pq;
        float* MOD = (float*)(P.ws + WS_MOD); float* XCTX = (float*)(P.ws + WS_XCTX); float* GATES = (float*)(P.ws + WS_GATES);
        bf16_t* HY = (bf16_t*)(P.ws + WS_HY); bf16_t* PROJ = (bf16_t*)(P.ws + WS_PROJ);
        int tid = threadIdx.x; asm volatile("" : "+v"(tid));
        const int lane = tid & 63, wave = __builtin_amdgcn_readfirstlane(tid >> 6);
#ifdef DBG_SCAN
        if (ph0 == 0 && blockIdx.x == 0 && tid == 0) *(unsigned*)(P.ws + 900000) = 0u;
#ifndef DBG_P1
        if (ph0 == 36) dbg_scan(P, tid);
#endif
        if (ph0 == 37) { const unsigned fl = *(volatile unsigned*)(P.ws + 900000); for (size_t i = (size_t)blockIdx.x * 512 + tid; i < (size_t)MLAT * D; i += (size_t)gridDim.x * 512) P.out[i] = 1000.f * (float)fl; }
        else
#endif
        if ((FUSE8 && ph0 == 37) || (FUSE5 && ph0 == 34)) continue;
        if (LNF && ph0 >= 1 && ph0 < 37) { const int s_ = (ph0 - 1) % 9, l_ = (ph0 - 1) / 9; if (s_ == 6 || (s_ == 0 && l_ > 0)) continue; }
        if (ph == 99) {} else if (ph == 0) { if (PHSEL & 1) phase_prologue(P, lds, tid, wave, lane); }
        else if (ph == 37) { if (PHSEL & 2) {
#if LNF
            phase_final_bf16(HY, (const float*)(P.ws + WS_PARTA), P.out, P.in[21], wave, lane);
#else
            phase_final(P.out, P.in[21], wave, lane);
#endif
        } }
        else {
            const int l = (ph - 1) / 9, s = (ph - 1) % 9; const int Mrows = (l == 3) ? MLAT : MTOT; const float* modl = MOD + (size_t)l * 9 * 6144;
            if (s == 0) { if (PHSEL & (4 << 0)) {
#if LNF
                if (l == 0) phase_first(P, lds, tid, wave, lane);
#else
                if (l == 0) phase_norm(P.in[0], P.in[2], P.out, XCTX, P.in[4], modl, 0, 1, HY, 0, MTOT, wave, lane);
                else phase_norm(P.out, XCTX, nullptr, nullptr, P.in[4] + l * D, modl, 0, 1, HY, FUSE8 ? MLAT : 0, MTOT, wave, lane);
#endif
            } } else if (s == 1) { if (PHSEL & (4 << 1)) {
                pg8::Gemm g{HY, (const bf16_t*)(P.ws + WS_WIN) + (size_t)l * NINP * 1024, MTOT, NINP, 1024}; pg8::StaticOrder S; S.init(MTOT, NINP, G, (int)blockIdx.x);
#if LNF
                EpiProjN E{PROJ, GATES, l & 1, (const float*)(P.ws + WS_PARTA), (const float*)(P.ws + WS_SHW1) + (size_t)l * 9 * NINP, (LAS float*)(lds + 131072)};
#if defined(NULLDUP) && NULLDUP == 2
                if (ph00 & 1) { EpiNull EN{(float*)P.ws}; pg8::gemm_phase<EpiNull, pg8::StaticOrder, false>(lds, g, S, EN, nullptr, tid); } else
#endif
                pg8::gemm_phase<EpiProjN, pg8::StaticOrder, false>(lds, g, S, E, nullptr, tid);
#else
                EpiProj E{PROJ, GATES, l & 1};
                pg8::gemm_phase<EpiProj, pg8::StaticOrder, false>(lds, g, S, E, nullptr, tid);
#endif
            } } else if (s == 2) { if (PHSEL & (4 << 2)) {
                phase_mix1(P, lds, l, tid, wave, lane);
            } } else if (s == 3) { if (PHSEL & (4 << 3)) {
                phase_scan_sgu(P, lds, l, tid, wave, lane);
            } } else if (s == 4) { if (PHSEL & (4 << 4)) {
                phase_mix3(P, lds, l, tid, wave, lane);
            } } else if (s == 5) { if (PHSEL & (4 << 5)) {
                pg8::Gemm g{HY, (const bf16_t*)(P.ws + WS_WOUT) + (size_t)l * 1024 * 1024, Mrows, 1024, 1024};
                EpiRes E{P.out, XCTX, modl + 2 * 1024, l & 1};
#if FUSE5
                PanelOrder S; S.init(G, (int)blockIdx.x, (l == 3) ? 0 : 32);
                pg8::gemm_phase<EpiRes, PanelOrder, false>(lds, g, S, E, nullptr, tid);
                __builtin_amdgcn_fence(__ATOMIC_ACQUIRE, "agent"); asm volatile("s_waitcnt vmcnt(0)" ::: "memory");
                panel_norm(P.out, P.in[5] + l * D, modl, 3, 4, (bf16_t*)(P.ws + WS_STA), l & 1, 0, wave, lane);
#else
                pg8::StaticOrder S; S.init(Mrows, 1024, G, (int)blockIdx.x);
#if LNF
                EpiResN EN{P.out, XCTX, modl + 2 * 1024, l & 1, (bf16_t*)(P.ws + WS_STA), (const float*)(P.ws + WS_GM) + (size_t)(l * 2 + 1) * 9 * 1024, (float*)(P.ws + WS_PARTB), (l == 0) ? P.in[0] : (const float*)P.out, (l == 0) ? P.in[2] : (const float*)XCTX, 0};
#ifdef NULLDUP
                if (ph00 & 1) { EpiNull EZ{(float*)P.ws}; pg8::gemm_phase<EpiNull, pg8::StaticOrder, false>(lds, g, S, EZ, nullptr, tid); } else
#endif
                pg8::gemm_phase<EpiResN, pg8::StaticOrder, false>(lds, g, S, EN, nullptr, tid);
#else
                pg8::gemm_phase<EpiRes, pg8::StaticOrder, false>(lds, g, S, E, nullptr, tid);
#endif
#endif
            } } else if (s == 6) { if (PHSEL & (4 << 6)) {
#if !LNF
                phase_norm(P.out, XCTX, nullptr, nullptr, P.in[5] + l * D, modl, 3, 4, (bf16_t*)(P.ws + WS_STA), FUSE5 ? MLAT : 0, Mrows, wave, lane);
#endif
            } } else if (s == 7) { if (PHSEL & (4 << 7)) {
                pg8::Gemm g{(const bf16_t*)(P.ws + WS_STA), (const bf16_t*)(P.ws + WS_WFI) + (size_t)l * 5632 * 1024, Mrows, 5632, 1024}; pg8::StaticOrder S; S.init(Mrows, 5632, G, (int)blockIdx.x);
#if LNF
                EpiFfnN E{PROJ, (const float*)(P.ws + WS_PARTB), (const float*)(P.ws + WS_SHW2) + (size_t)l * 9 * 5632, (LAS float*)(lds + 131072)};
#if defined(NULLDUP) && NULLDUP == 2
                if (ph00 & 1) { EpiNull EN{(float*)P.ws}; pg8::gemm_phase<EpiNull, pg8::StaticOrder, false>(lds, g, S, EN, nullptr, tid); } else
#endif
                pg8::gemm_phase<EpiFfnN, pg8::StaticOrder, false>(lds, g, S, E, nullptr, tid);
#else
                EpiFfn E{PROJ};
                pg8::gemm_phase<EpiFfn, pg8::StaticOrder, false>(lds, g, S, E, nullptr, tid);
#endif
            } } else { if (PHSEL & (4 << 8)) {
                pg8::Gemm g{PROJ, (const bf16_t*)(P.ws + WS_WFO) + (size_t)l * 1024 * DFF, Mrows, 1024, DFF};
                EpiRes E{P.out, XCTX, modl + 5 * 1024, 0};
#if FUSE8
                PanelOrder S; S.init(G, (int)blockIdx.x, (l == 3) ? 0 : 32);
                pg8::gemm_phase<EpiRes, PanelOrder, false>(lds, g, S, E, nullptr, tid);
                __builtin_amdgcn_fence(__ATOMIC_ACQUIRE, "agent"); asm volatile("s_waitcnt vmcnt(0)" ::: "memory");
                if (l < 3) panel_norm(P.out, P.in[4] + (l + 1) * D, modl + 9 * 6144, 0, 1, HY, 0, 0, wave, lane);
                else panel_norm(P.out, P.in[21], nullptr, 0, 0, nullptr, 0, 1, wave, lane);
#else
                pg8::StaticOrder S; S.init(Mrows, 1024, G, (int)blockIdx.x);
#if LNF
                EpiResN EN{P.out, XCTX, modl + 5 * 1024, 0, HY, (const float*)(P.ws + WS_GM) + (size_t)((l < 3 ? l + 1 : 3) * 2 + 0) * 9 * 1024, (float*)(P.ws + WS_PARTA), (const float*)P.out, (const float*)XCTX, (l == 3) ? 1 : 0};
#ifdef NULLDUP
                if (ph00 & 1) { EpiNull EZ{(float*)P.ws}; pg8::gemm_phase<EpiNull, pg8::StaticOrder, false>(lds, g, S, EZ, nullptr, tid); } else
#endif
                pg8::gemm_phase<EpiResN, pg8::StaticOrder, false>(lds, g, S, EN, nullptr, tid);
#else
                pg8::gemm_phase<EpiRes, pg8::StaticOrder, false>(lds, g, S, E, nullptr, tid);
#endif
#endif
            } }
        }
        if (ph00 + 1 < 2 * P.ph_hi) {
            if (P.ph_lo < 0) {
                __builtin_amdgcn_fence(__ATOMIC_RELEASE, "agent"); asm volatile("s_waitcnt vmcnt(0)" ::: "memory");
                grid.sync();
                __builtin_amdgcn_fence(__ATOMIC_ACQUIRE, "agent"); asm volatile("s_waitcnt vmcnt(0)" ::: "memory");
            } else xcd_barrier(bar);
#ifdef EXTRA_SYNC
            for (int xs = 0; xs < EXTRA_SYNC; ++xs) xcd_barrier(bar);
#endif
        }
    }
}

extern "C" void kernel_launch(void* const* d_in, const int* in_sizes, int n_in, void* d_out, int out_size, void* d_ws, size_t ws_size, hipStream_t stream) {
    static int grid = 0;
    if (grid == 0) {
        if (n_in != 22 || out_size != MLAT * D || ws_size < WS_END) { fprintf(stderr, "kernel_launch: unexpected shapes (n_in %d out %d ws %zu)\n", n_in, out_size, ws_size); grid = -1; return; }
        int dev = 0, cus = 0, per_cu = 0;
        hipGetDevice(&dev); hipDeviceGetAttribute(&cus, hipDeviceAttributeMultiprocessorCount, dev);
        if (hipFuncSetAttribute((const void*)hybrid_fwd, hipFuncAttributeMaxDynamicSharedMemorySize, LDS_BYTES) != hipSuccess) { fprintf(stderr, "kernel_launch: hipFuncSetAttribute failed\n"); grid = -1; return; }
        if (hipOccupancyMaxActiveBlocksPerMultiprocessor(&per_cu, (const void*)hybrid_fwd, 512, LDS_BYTES) != hipSuccess || per_cu < 1) { fprintf(stderr, "kernel_launch: occupancy query says %d\n", per_cu); per_cu = 1; }
        (void)hipGetLastError();
        grid = cus * per_cu;
    }
    if (grid < 0) return;
    if (hipMemsetAsync((char*)d_ws + WS_BAR, 0, XCD_BAR_WORDS * 4, stream) != hipSuccess) { fprintf(stderr, "kernel_launch: memset failed\n"); return; }
    Params p{};
    for (int i = 0; i < 22; ++i) p.in[i] = (const float*)d_in[i];
    p.out = (float*)d_out; p.ws = (unsigned char*)d_ws; p.ph_lo = 0; p.ph_hi = FUSE8 ? 37 : 38;
    void* args[] = {&p};
    hipError_t e = hipLaunchCooperativeKernel((const void*)hybrid_fwd, dim3(grid), dim3(512), args, LDS_BYTES, stream);
    if (e != hipSuccess) fprintf(stderr, "cooperative launch failed: %s (grid %d)\n", hipGetErrorString(e), grid);
}
```
